# Optimizing an MI355X kernel written in HIP

```python
import math
import jax, jax.numpy as jnp
from jax import lax
import numpy as np

D_MODEL = 1024
BATCH = 8
SEQ = 4096
DEPTH = 1

GRID_W = 64
HEAD_DIM = 64
NA_HEADS = 8
NA_WIDTH = NA_HEADS * HEAD_DIM
NA_KH_MAX = 8
NA_KW = 16
NA_COL_BLOCK = 16
NA_KEY_COLS = 32
DIFF_HEADS = 4
DIFF_WIDTH = DIFF_HEADS * 2 * HEAD_DIM
MIX_WIDTH = NA_WIDTH + DIFF_WIDTH
IN_WIDTH = 3 * NA_WIDTH + 3 * DIFF_WIDTH
N_EXPERTS = 16
EC_CAPACITY_FACTOR = 2
D_FF_EXPERT = 1024
PLE_DIM = 256
Q_BLOCK = 128
EPS = 1e-6

kernel_name = "hybrid_na_diffattn_ec_moe_encoder"


def rmsnorm(x, g):
    xf = x.astype(jnp.float32)
    y = xf * lax.rsqrt(jnp.mean(xf * xf, axis=-1, keepdims=True) + EPS)
    return (y * g.astype(jnp.float32)).astype(x.dtype)


def alibi_slopes(n_heads):
    return jnp.exp2(-8.0 * jnp.arange(1, n_heads + 1, dtype=jnp.float32) / n_heads)


def neighbourhood_attention(q, k, v, rpb):
    B, S, H, dh = q.shape
    rows = S // GRID_W
    kh = min(NA_KH_MAX, rows)
    ncb = GRID_W // NA_COL_BLOCK
    qg = q.reshape(B, rows, ncb, NA_COL_BLOCK, H, dh)
    kg = k.reshape(B, rows, GRID_W, H, dh)
    vg = v.reshape(B, rows, GRID_W, H, dh)
    qcol = np.arange(GRID_W).reshape(ncb, NA_COL_BLOCK)
    kblk = np.clip(np.arange(ncb) * NA_COL_BLOCK - NA_KW // 2, 0, GRID_W - NA_KEY_COLS)
    kcol = kblk[:, None] + np.arange(NA_KEY_COLS)
    cstart = np.clip(qcol - NA_KW // 2, 0, GRID_W - NA_KW)
    kc = kcol[:, None, :]
    col_ok = (kc >= cstart[..., None]) & (kc < cstart[..., None] + NA_KW)
    dc = np.clip(kc - qcol[..., None] + NA_KW - 1, 0, 2 * NA_KW - 2)
    rpb_c = rpb[:, :, dc].astype(jnp.float32)
    mask = jnp.asarray(col_ok)[:, :, None, :]

    def row(r):
        rs = jnp.clip(r - kh // 2, 0, rows - kh)
        q_r = lax.dynamic_index_in_dim(qg, r, axis=1, keepdims=False)
        k_rows = lax.dynamic_slice_in_dim(kg, rs, kh, axis=1)
        v_rows = lax.dynamic_slice_in_dim(vg, rs, kh, axis=1)
        k_b = k_rows[:, :, kcol]
        v_b = v_rows[:, :, kcol]
        dr = rs + jnp.arange(kh) - r + NA_KH_MAX - 1
        bias = rpb_c[:, dr].transpose(0, 2, 3, 1, 4)
        s = jnp.einsum('bnqhd,brnjhd->bhnqrj', q_r, k_b).astype(jnp.float32)
        s = jnp.where(mask, s + bias[None], -jnp.inf)
        pr = jax.nn.softmax(s, axis=(-2, -1))
        o = jnp.einsum('bhnqrj,brnjhd->bnqhd', pr.astype(v.dtype), v_b)
        return o.reshape(B, GRID_W, H, dh)

    o = lax.map(row, jnp.arange(rows))
    return o.transpose(1, 0, 2, 3, 4).reshape(B, S, H, dh)


def differential_attention(q, k, v, lam, slopes):
    B, S, H, _, dh = q.shape
    nb = S // Q_BLOCK
    qb = q.reshape(B, nb, Q_BLOCK, H, 2, dh).transpose(1, 0, 2, 3, 4, 5)
    kpos = jnp.arange(S, dtype=jnp.float32)

    def block(args):
        q_i, i = args
        s = jnp.einsum('bqhcd,bkhcd->bhcqk', q_i, k).astype(jnp.float32)
        qpos = (i * Q_BLOCK + jnp.arange(Q_BLOCK)).astype(jnp.float32)
        dist = jnp.abs(qpos[:, None] - kpos[None, :])
        s = s - slopes[:, None, None, None] * dist
        pr = jax.nn.softmax(s, axis=-1)
        a = pr[:, :, 0] - lam * pr[:, :, 1]
        return jnp.einsum('bhqk,bkhe->bqhe', a.astype(v.dtype), v)

    o = lax.map(block, (qb, jnp.arange(nb)))
    return o.transpose(1, 0, 2, 3, 4).reshape(B, S, H, 2 * dh)


def expert_choice_moe(x, w_router, w_gate, w_up, w_down):
    B, S, D = x.shape
    cap = EC_CAPACITY_FACTOR * S // N_EXPERTS
    aff = jax.nn.softmax((x @ w_router).astype(jnp.float32), axis=-1)
    g, idx = lax.top_k(aff.transpose(0, 2, 1), cap)
    xs = jax.vmap(lambda xb, ib: xb[ib])(x, idx)
    hid = jax.nn.silu(jnp.einsum('becd,edf->becf', xs, w_gate)) * jnp.einsum('becd,edf->becf', xs, w_up)
    y = jnp.einsum('becf,efd->becd', hid, w_down) * g[..., None].astype(x.dtype)
    return jax.vmap(lambda yb, ib: jax.ops.segment_sum(
        yb.reshape(-1, D), ib.reshape(-1), num_segments=S))(y, idx)


def setup_inputs(seed: int = 0) -> dict:
    key = jax.random.key(seed)
    ks = jax.random.split(key, 24)
    f32 = jnp.float32
    nrm = lambda k, shape, scale: jax.random.normal(k, shape, f32) * scale
    gain = lambda k, shape: 1.0 + 0.05 * jax.random.normal(k, shape, f32)
    L, D, E, F = DEPTH, D_MODEL, N_EXPERTS, D_FF_EXPERT
    return {
        "x": nrm(ks[0], (BATCH, SEQ, D), 1.0),
        "p": nrm(ks[1], (L, BATCH, SEQ, PLE_DIM), 1.0),
        "g_mix": gain(ks[2], (L, D)),
        "w_in": nrm(ks[3], (L, D, IN_WIDTH), D ** -0.5),
        "na_rpb": nrm(ks[4], (L, NA_HEADS, 2 * NA_KH_MAX - 1, 2 * NA_KW - 1), 0.02),
        "g_na_out": gain(ks[5], (L, NA_HEADS, HEAD_DIM)),
        "lam_q1": nrm(ks[6], (L, HEAD_DIM), 0.1),
        "lam_k1": nrm(ks[7], (L, HEAD_DIM), 0.1),
        "lam_q2": nrm(ks[8], (L, HEAD_DIM), 0.1),
        "lam_k2": nrm(ks[9], (L, HEAD_DIM), 0.1),
        "g_diff_out": gain(ks[10], (L, 2 * HEAD_DIM)),
        "w_out": nrm(ks[11], (L, MIX_WIDTH, D), MIX_WIDTH ** -0.5),
        "g_moe": gain(ks[12], (L, D)),
        "w_router": nrm(ks[13], (L, D, E), D ** -0.5),
        "w_gate": nrm(ks[14], (L, E, D, F), D ** -0.5),
        "w_up": nrm(ks[15], (L, E, D, F), D ** -0.5),
        "w_down": nrm(ks[16], (L, E, F, D), F ** -0.5),
        "g_ple": gain(ks[17], (L, D)),
        "w_ple_gate": nrm(ks[18], (L, D, D), D ** -0.5),
        "w_ple_proj": nrm(ks[19], (L, PLE_DIM, D), PLE_DIM ** -0.5),
        "g_final": gain(ks[20], (D,)),
    }


def reference(x, p, g_mix, w_in, na_rpb, g_na_out, lam_q1, lam_k1, lam_q2, lam_k2,
              g_diff_out, w_out, g_moe, w_router, w_gate, w_up, w_down,
              g_ple, w_ple_gate, w_ple_proj, g_final):
    B, S, D = x.shape
    scale = HEAD_DIM ** -0.5
    slopes = alibi_slopes(DIFF_HEADS)
    splits = [NA_WIDTH, 2 * NA_WIDTH, 3 * NA_WIDTH,
              3 * NA_WIDTH + DIFF_WIDTH, 3 * NA_WIDTH + 2 * DIFF_WIDTH]
    h = x
    for i in range(DEPTH):
        hn = rmsnorm(h, g_mix[i])
        proj = hn @ w_in[i]
        q_na, k_na, v_na, q_df, k_df, v_df = jnp.split(proj, splits, axis=-1)

        o_na = neighbourhood_attention(
            q_na.reshape(B, S, NA_HEADS, HEAD_DIM) * scale,
            k_na.reshape(B, S, NA_HEADS, HEAD_DIM),
            v_na.reshape(B, S, NA_HEADS, HEAD_DIM),
            na_rpb[i])
        o_na = rmsnorm(o_na, g_na_out[i]).reshape(B, S, NA_WIDTH)

        lam_init = 0.8 - 0.6 * math.exp(-0.3 * i)
        lam = (jnp.exp(jnp.sum(lam_q1[i].astype(jnp.float32) * lam_k1[i].astype(jnp.float32)))
               - jnp.exp(jnp.sum(lam_q2[i].astype(jnp.float32) * lam_k2[i].astype(jnp.float32)))
               + lam_init)
        o_df = differential_attention(
            q_df.reshape(B, S, DIFF_HEADS, 2, HEAD_DIM) * scale,
            k_df.reshape(B, S, DIFF_HEADS, 2, HEAD_DIM),
            v_df.reshape(B, S, DIFF_HEADS, 2 * HEAD_DIM),
            lam, slopes)
        o_df = (rmsnorm(o_df, g_diff_out[i]) * (1.0 - lam_init)).reshape(B, S, DIFF_WIDTH)

        h = h + jnp.concatenate([o_na, o_df], axis=-1) @ w_out[i]

        h = h + expert_choice_moe(rmsnorm(h, g_moe[i]), w_router[i],
                                  w_gate[i], w_up[i], w_down[i])

        h = h + jax.nn.sigmoid(rmsnorm(h, g_ple[i]) @ w_ple_gate[i]) * (p[i] @ w_ple_proj[i])
    return rmsnorm(h, g_final)
```

```cpp
#include <hip/hip_runtime.h>
#include <stdint.h>
#include <cstdio>

#ifndef NAIVE_MASK
#define NAIVE_MASK 0x0
#endif

#ifndef P2_MODE
#define P2_MODE 3
#endif
#ifndef P2_RUN
#define P2_RUN 3
#endif
#ifndef CUT_MASK
#define CUT_MASK 0x0
#endif
#define GAS __attribute__((address_space(1)))
#define LAS __attribute__((address_space(3)))
typedef unsigned short bf16_t;
typedef short bf16x8 __attribute__((ext_vector_type(8)));
typedef float f32x4 __attribute__((ext_vector_type(4)));
typedef float f32x16 __attribute__((ext_vector_type(16)));
typedef unsigned u32x4 __attribute__((ext_vector_type(4)));
typedef unsigned u32x2 __attribute__((ext_vector_type(2)));

constexpr int B = 8, S = 4096, D = 1024, T = B * S;
constexpr int GW = 64, ROWS = 64, NAH = 8, DFH = 4;
constexpr int INW = 3072, NQK = 2048, NV = 1024, E = 16, CAP = 512, FF = 1024, PLE = 256, MROWS = B * E * CAP;
constexpr float EPS = 1e-6f;
constexpr float LOG2E = 1.4426950408889634f;
constexpr float QSCALE = 0.125f * LOG2E;

constexpr size_t MiB = 1u << 20;
constexpr size_t WS_CTL = 0, CTL_ZERO_BYTES = 1 * MiB;
constexpr size_t WS_SSQ = 512 * 1024;
constexpr size_t WS_R1 = 1 * MiB, WS_R2 = WS_R1 + 128 * 1024, WS_R3 = WS_R2 + 128 * 1024;
constexpr size_t WS_TOK = WS_R1 + 512 * 1024, WS_GSEL = WS_TOK + 256 * 1024, WS_RSEL = WS_GSEL + 256 * 1024;
constexpr size_t WS_AFF = 2 * MiB + 256 * 1024;
constexpr size_t WS_INV = 4 * MiB + 512 * 1024;
constexpr size_t WS_WQK = 8 * MiB, WS_WV = 12 * MiB, WS_WOUT = 14 * MiB, WS_WPG = 16 * MiB, WS_WPP = 18 * MiB, WS_WGU = 19 * MiB, WS_WDN = 83 * MiB;
constexpr size_t WS_XB = 116 * MiB;
constexpr size_t WS_PB = 180 * MiB;
constexpr size_t WS_QK = 196 * MiB;
constexpr size_t WS_VT = 324 * MiB;
constexpr size_t WS_END = 452 * MiB;
constexpr int CW_BAR = 1024;

constexpr int RING_BYTES = 131072, TOKL_OFF = RING_BYTES, TOKL_BYTES = 8192, MISC_OFF = TOKL_OFF + TOKL_BYTES, LDS_BYTES = 147456;

#define RLX_AGENT __ATOMIC_RELAXED, __HIP_MEMORY_SCOPE_AGENT
#define LDS_WAIT() asm volatile("s_waitcnt lgkmcnt(0)" ::: "memory")
__device__ __forceinline__ unsigned f2bf(float f) { unsigned u = __builtin_bit_cast(unsigned, f); return (u + 0x7fffu + ((u >> 16) & 1u)) >> 16; }
__device__ __forceinline__ unsigned pk2(float lo, float hi) { return f2bf(lo) | (f2bf(hi) << 16); }
__device__ __forceinline__ float bf2f(unsigned short v) { return __builtin_bit_cast(float, (unsigned)v << 16); }
__device__ __forceinline__ float bflo(unsigned w) { return __builtin_bit_cast(float, w << 16); }
__device__ __forceinline__ float bfhi(unsigned w) { return __builtin_bit_cast(float, w & 0xffff0000u); }
__device__ __forceinline__ float wave_sum(float v) {
#pragma unroll
  for (int o = 32; o > 0; o >>= 1) v += __shfl_xor(v, o);
  return v;
}
__device__ __forceinline__ float lam_value(const float* q1, const float* k1, const float* q2, const float* k2) {
  float s1 = 0.f, s2 = 0.f;
  for (int i = 0; i < 64; ++i) { s1 += q1[i] * k1[i]; s2 += q2[i] * k2[i]; }
  return expf(s1) - expf(s2) + 0.2f;
}

#define XB_TMO      128
#define XB_XCNT(j)  (256  + 64 * (j))
#define XB_XSUB(j)  (1280 + 64 * (j))
#define XB_XGEN(j)  (2304 + 64 * (j))
#define XB_TOP      3328
#define XB_TOPGEN   3392
#define XCD_BAR_WORDS 3456
#define XB_SPIN_CAP (1u << 18)
__device__ __forceinline__ unsigned xb_ld(unsigned* p)              { return __hip_atomic_load(p, __ATOMIC_RELAXED, __HIP_MEMORY_SCOPE_AGENT); }
__device__ __forceinline__ unsigned xb_add(unsigned* p, unsigned v) { return __hip_atomic_fetch_add(p, v, __ATOMIC_RELAXED, __HIP_MEMORY_SCOPE_AGENT); }
__device__ __forceinline__ unsigned xb_xcc_id() { return (unsigned)__builtin_amdgcn_s_getreg((3 << 11) | 20) & 0xFu; }
#define XB_SPIN(cond, bar) do { unsigned _sp = 0; while (cond) { __builtin_amdgcn_s_sleep(1); \
    if ((++_sp & 255u) == 0u) { if (xb_ld(&(bar)[XB_TMO])) break; if (_sp > XB_SPIN_CAP) { atomicAdd(&(bar)[XB_TMO], 1u); break; } } } } while (0)
struct XcdBarrier { unsigned* bar; unsigned x; volatile LAS unsigned* st; };
__device__ __forceinline__ XcdBarrier xcd_barrier_post(unsigned* bar, volatile LAS unsigned* st) {
  XcdBarrier b; b.bar = bar; b.x = xb_xcc_id(); b.st = st;
  if (threadIdx.x == 0) (void)xb_add(&bar[XB_XCNT(b.x)], 1u);
  return b;
}
__device__ __forceinline__ void xcd_barrier_complete(unsigned* bar, unsigned x, unsigned& nloc, unsigned& nx) {
  const unsigned G = gridDim.x * gridDim.y * gridDim.z;
  unsigned sum, cnt, mine, sp = 0u;
  for (;;) {
    sum = 0u; cnt = 0u; mine = 0u;
#pragma unroll
    for (unsigned j = 0; j < 16; ++j) { const unsigned c = xb_ld(&bar[XB_XCNT(j)]); sum += c; cnt += (c > 0u) ? 1u : 0u; mine = (j == x) ? c : mine; }
    if (sum == G) break;
    __builtin_amdgcn_s_sleep(1);
    if ((++sp & 255u) == 0u) { if (xb_ld(&bar[XB_TMO])) break; if (sp > XB_SPIN_CAP) { atomicAdd(&bar[XB_TMO], 1u); break; } }
  }
  nloc = mine > 0u ? mine : 1u; nx = cnt > 0u ? cnt : 1u;
}
__device__ __forceinline__ void xcd_barrier(const XcdBarrier& b) {
  asm volatile("s_waitcnt vmcnt(0)" ::: "memory");
  __syncthreads();
  if (threadIdx.x == 0) {
    unsigned* bar = b.bar;
    __builtin_amdgcn_s_waitcnt(0);
    unsigned nloc = b.st[0], nx = b.st[1];
    if (nloc == 0u) { xcd_barrier_complete(bar, b.x, nloc, nx); b.st[0] = nloc; b.st[1] = nx; }
    const unsigned old = xb_add(&bar[XB_XSUB(b.x)], 1u);
    const unsigned gen = old / nloc;
    if (old + 1u == (gen + 1u) * nloc) {
      __builtin_amdgcn_fence(__ATOMIC_RELEASE, "agent");
      asm volatile("s_waitcnt vmcnt(0)" ::: "memory");
      const unsigned og = xb_add(&bar[XB_TOP], 1u);
      const unsigned tg = og / nx;
      if (og + 1u == (tg + 1u) * nx) xb_add(&bar[XB_TOPGEN], 1u);
      else XB_SPIN(xb_ld(&bar[XB_TOPGEN]) == tg, bar);
      __builtin_amdgcn_fence(__ATOMIC_ACQUIRE, "agent");
      xb_add(&bar[XB_XGEN(b.x)], 1u);
      asm volatile("s_waitcnt vmcnt(0)" ::: "memory");
    } else {
      XB_SPIN(xb_ld(&bar[XB_XGEN(b.x)]) == gen, bar);
      __builtin_amdgcn_fence(__ATOMIC_ACQUIRE, "agent");
      asm volatile("s_waitcnt vmcnt(0)" ::: "memory");
    }
  }
  __syncthreads();
}

namespace pg8 {
constexpr int BM = 256, BK = 64, HALF = 128, HTB = HALF * BK * 2, STAGE_BYTES = 8 * HTB, NXCD = 8, WGM = 8;
__host__ __device__ __forceinline__ int lds_byte(int r, int c) { const int st = (r >> 4) * 2 + (c >> 5), rr = r & 15, cc = c & 31, ob = rr * 64 + cc * 2; return st * 1024 + (ob ^ (((ob >> 9) & 1) << 5)); }
__host__ __device__ __forceinline__ void stage_rc(int b, int& R, int& C) { const int st = b / 1024, sb = b % 1024, swz = sb ^ (((sb >> 9) & 1) << 5); R = (st >> 1) * 16 + swz / 64; C = (st & 1) * 32 + (swz % 64) / 2; }
__host__ __device__ __forceinline__ int perm32(int rho) { const int n = rho >> 4, i = rho & 15; return 8 * (i >> 2) + 4 * n + (i & 3); }
struct Unit { int pm, pn, z; };
struct OrderStd {
  int nM, nN, nwg, G, c; size_t tstep;
  __device__ void init(int M, int N, int K, int G_, int c_) { nM = M / BM; nN = N / BM; nwg = nM * nN; G = G_; c = c_; tstep = (size_t)BM * K * 2; }
  __device__ bool next(int i, Unit& u) const {
    const long L = (long)i * G + c; if (L >= nwg) return false;
    int wgid = (int)L; { const int q = nwg / NXCD, r = nwg % NXCD, xcd = wgid % NXCD, off = wgid / NXCD; wgid = (xcd < r ? xcd * (q + 1) : r * (q + 1) + (xcd - r) * q) + off; }
    const int nig = WGM * nN, gid = wgid / nig, fm = gid * WGM, gsz = (nM - fm) < WGM ? (nM - fm) : WGM;
    u.pm = fm + ((wgid % nig) % gsz); u.pn = (wgid % nig) / gsz; u.z = 0; return true;
  }
  __device__ size_t aoff(const Unit& u) const { return (size_t)u.pm * tstep; }
  __device__ size_t boff(const Unit& u) const { return (size_t)u.pn * tstep; }
};
struct OrderMoe {
  int G, vcu, upe, npn, total; size_t tstepA, tstepB, estepB;
  __device__ bool next(int i, Unit& u) const {
    const int L = i * G + vcu; if (L >= total) return false;
    const int e = L / upe, rem = L % upe, pnl = rem % npn, bp = rem / npn, b = bp >> 1, pml = bp & 1;
    u.z = b * E + e; u.pm = u.z * 2 + pml; u.pn = pnl; return true;
  }
  __device__ size_t aoff(const Unit& u) const { return (size_t)u.pm * tstepA; }
  __device__ size_t boff(const Unit& u) const { return (size_t)(u.z & (E - 1)) * estepB + (size_t)u.pn * tstepB; }
};
typedef float f32x2_t __attribute__((ext_vector_type(2))); typedef __bf16 bf16x2_t __attribute__((ext_vector_type(2)));
__device__ __forceinline__ unsigned cvt_pk_bf16(float lo, float hi) { f32x2_t v = {lo, hi}; bf16x2_t bb = __builtin_convertvector(v, bf16x2_t); return __builtin_bit_cast(unsigned, bb); }

template <class Epi, class Sched, bool ALIGN_EPI, bool GATHER>
__device__ __forceinline__ void gemm_phase(LAS unsigned char* lds, const char* Abase, const char* Bbase, int K, const Sched& S, const Epi& E, const LAS int* tokL) {
  const int tid = threadIdx.x, wid = __builtin_amdgcn_readfirstlane(tid >> 6), lane = tid & 63, wr = wid >> 2, wc = wid & 3, fr = lane & 15, fq = lane >> 4;
  const int nt = K / BK;
  unsigned voffA[2], voffB[2]; int RA[2], CA2[2];
#pragma unroll
  for (int i = 0; i < 2; ++i) { int R, C; stage_rc(tid * 16 + i * 8192, R, C); const int Rb = Epi::PERM ? ((R & ~31) + perm32(R & 31)) : R;
    voffA[i] = (unsigned)(R * K + C) * 2u; voffB[i] = (unsigned)(Rb * K + C) * 2u; RA[i] = R; CA2[i] = C * 2; }
  const size_t kstep = (size_t)(BK * 2);
  const size_t hstep = (size_t)HALF * K * 2;
  const unsigned ldsw = (unsigned)wid * 1024u;
  const int aoff = lds_byte(wr * 64 + fr, fq * 8), boff = lds_byte(wc * 32 + fr, fq * 8);
#define PG8_SA(b, h) (((b) * 2 + (h)) * HTB)
#define PG8_SB(b, h) ((4 + (b) * 2 + (h)) * HTB)
#define PG8_ST2(bufoff, gptr, o0, o1) do { \
    __builtin_amdgcn_global_load_lds((const unsigned*)((const char*)(gptr) + (o0)), (LAS unsigned*)(lds + (bufoff) + ldsw), 16, 0, 0); \
    __builtin_amdgcn_global_load_lds((const unsigned*)((const char*)(gptr) + (o1)), (LAS unsigned*)(lds + (bufoff) + ldsw + 8192), 16, 0, 0); } while (0)
#define PG8_STB(b, h, ptr) PG8_ST2(PG8_SB(b, h), (ptr) + (h) * hstep, voffB[0], voffB[1])
#define PG8_STA(b, h, nx, kto) do { if constexpr (GATHER) { const unsigned o0_ = (nx) ? gN[h][0] : gC[h][0], o1_ = (nx) ? gN[h][1] : gC[h][1]; PG8_ST2(PG8_SA(b, h), Abase + (kto), o0_, o1_); } \
    else { const char* ap_ = (nx) ? nA : cA; PG8_ST2(PG8_SA(b, h), ap_ + (h) * hstep + (kto), voffA[0], voffA[1]); } } while (0)
#define PG8_LDA(dst, b, h) do { _Pragma("unroll") for (int m = 0; m < 4; ++m) _Pragma("unroll") for (int k = 0; k < 2; ++k) dst[m][k] = *(const LAS bf16x8*)(lds + PG8_SA(b, h) + aoff + m * 2048 + k * 1024); } while (0)
#define PG8_LDB(dst, b, h) do { _Pragma("unroll") for (int n = 0; n < 2; ++n) _Pragma("unroll") for (int k = 0; k < 2; ++k) dst[n][k] = *(const LAS bf16x8*)(lds + PG8_SB(b, h) + boff + n * 2048 + k * 1024); } while (0)
#define PG8_MMA(ai, bj, At, Bt) do { __builtin_amdgcn_s_setprio(1); _Pragma("unroll") for (int m = 0; m < 4; ++m) _Pragma("unroll") for (int n = 0; n < 2; ++n) _Pragma("unroll") for (int k = 0; k < 2; ++k) \
        acc[ai][bj][m][n] = __builtin_amdgcn_mfma_f32_16x16x32_bf16(Bt[n][k], At[m][k], acc[ai][bj][m][n], 0, 0, 0); __builtin_amdgcn_s_setprio(0); } while (0)
#define PG8_WAIT_V(n) asm volatile("s_waitcnt vmcnt(" #n ")" ::: "memory")
#define PG8_WAIT_L(n) asm volatile("s_waitcnt lgkmcnt(" #n ")" ::: "memory")
#define PG8_BAR __builtin_amdgcn_s_barrier()
#define PG8_SCHED __builtin_amdgcn_sched_barrier(0)
  Unit cur, nxt; int ui = 0;
  if (!S.next(0, cur)) return;
  f32x4 acc[2][2][4][2];
#pragma unroll
  for (int a = 0; a < 2; ++a)
#pragma unroll
    for (int b = 0; b < 2; ++b)
#pragma unroll
      for (int m = 0; m < 4; ++m)
#pragma unroll
        for (int n = 0; n < 2; ++n) acc[a][b][m][n] = (f32x4){0.f, 0.f, 0.f, 0.f};
  bf16x8 At[4][2], B0[2][2], B1[2][2];
  unsigned gC[2][2], gN[2][2];
  const char* cA = nullptr; const char* nA = nullptr;
  if constexpr (GATHER) {
#pragma unroll
    for (int h = 0; h < 2; ++h)
#pragma unroll
      for (int i = 0; i < 2; ++i) { gC[h][i] = (unsigned)tokL[h * HALF + RA[i]] * (unsigned)(K * 2) + (unsigned)CA2[i]; gN[h][i] = gC[h][i]; }
  } else { cA = Abase + S.aoff(cur); nA = cA; gC[0][0] = gN[0][0] = 0; (void)gC; (void)gN; }
  const char* cB = Bbase + S.boff(cur);
  const char* nB = cB;
  PG8_STB(0, 0, cB); PG8_STB(0, 1, cB); PG8_STA(0, 0, false, 0); PG8_STA(0, 1, false, 0);
  if (wr == 1) PG8_BAR;
  PG8_WAIT_V(2); PG8_BAR;
  PG8_STB(1, 0, cB + kstep); PG8_STA(1, 0, false, kstep); PG8_STB(1, 1, cB + kstep);
  PG8_WAIT_V(6); PG8_BAR;
  for (;;) {
    const bool has_next = S.next(ui + 1, nxt);
    if constexpr (GATHER) {
      if (has_next) {
#pragma unroll
        for (int h = 0; h < 2; ++h)
#pragma unroll
          for (int i = 0; i < 2; ++i) gN[h][i] = (unsigned)tokL[(ui + 1) * BM + h * HALF + RA[i]] * (unsigned)(K * 2) + (unsigned)CA2[i];
      } else {
#pragma unroll
        for (int h = 0; h < 2; ++h)
#pragma unroll
          for (int i = 0; i < 2; ++i) gN[h][i] = gC[h][i];
      }
    } else { nA = has_next ? Abase + S.aoff(nxt) : cA; }
    nB = has_next ? Bbase + S.boff(nxt) : cB;
    for (int t = 0; t < nt; t += 2) {
      const bool last = (t == nt - 2);
      const size_t k1 = (size_t)(t + 1) * kstep;
      const size_t k2 = last ? 0 : (size_t)(t + 2) * kstep, k3 = k2 + kstep;
      const char* b2 = (last ? nB : cB) + k2; const char* b3 = b2 + kstep;
      PG8_LDB(B0, 0, 0); PG8_LDB(B1, 0, 1); PG8_SCHED; PG8_LDA(At, 0, 0); PG8_STA(1, 1, false, k1);
      PG8_WAIT_V(8); PG8_WAIT_L(0); PG8_BAR; PG8_MMA(0, 0, At, B0); PG8_MMA(0, 1, At, B1); PG8_BAR; PG8_SCHED;
      PG8_LDA(At, 0, 1); PG8_STB(0, 0, b2); PG8_STB(0, 1, b2); PG8_STA(0, 0, last, k2);
      PG8_WAIT_V(8); PG8_WAIT_L(0); PG8_BAR; PG8_MMA(1, 0, At, B0); PG8_MMA(1, 1, At, B1); PG8_BAR; PG8_SCHED;
      PG8_LDB(B0, 1, 0); PG8_LDB(B1, 1, 1); PG8_SCHED; PG8_LDA(At, 1, 0); PG8_STA(0, 1, last, k2);
      PG8_WAIT_V(8); PG8_WAIT_L(0); PG8_BAR; PG8_MMA(0, 0, At, B0); PG8_MMA(0, 1, At, B1); PG8_BAR; PG8_SCHED;
      PG8_LDA(At, 1, 1); PG8_STB(1, 0, b3); PG8_STB(1, 1, b3); PG8_STA(1, 0, last, k3);
      PG8_WAIT_V(8); PG8_WAIT_L(0); PG8_BAR; PG8_MMA(1, 0, At, B0); PG8_MMA(1, 1, At, B1); PG8_BAR; PG8_SCHED;
    }
    if constexpr (ALIGN_EPI) { if (wr == 0) PG8_BAR; }
    E(acc, cur, wr, wc, fr, fq);
    if (!has_next) break;
#pragma unroll
    for (int a = 0; a < 2; ++a)
#pragma unroll
      for (int b = 0; b < 2; ++b)
#pragma unroll
        for (int m = 0; m < 4; ++m)
#pragma unroll
          for (int n = 0; n < 2; ++n) acc[a][b][m][n] = (f32x4){0.f, 0.f, 0.f, 0.f};
    cur = nxt; cA = nA; cB = nB; ++ui;
    if constexpr (GATHER) {
#pragma unroll
      for (int h = 0; h < 2; ++h)
#pragma unroll
        for (int i = 0; i < 2; ++i) gC[h][i] = gN[h][i];
    }
    if constexpr (ALIGN_EPI) { if (wr == 1) PG8_BAR; }
  }
  PG8_WAIT_V(0);
  if constexpr (!ALIGN_EPI) { if (wr == 0) PG8_BAR; }
  PG8_BAR;
#undef PG8_SA
#undef PG8_SB
#undef PG8_ST2
#undef PG8_STB
#undef PG8_STA
#undef PG8_LDA
#undef PG8_LDB
#undef PG8_MMA
#undef PG8_WAIT_V
#undef PG8_WAIT_L
#undef PG8_BAR
#undef PG8_SCHED
}

typedef const f32x4 (&AccT)[2][2][4][2];
struct EpiQK {
  static constexpr bool PERM = true;
  bf16_t* O; const float* rs;
  __device__ __forceinline__ void operator()(AccT acc, const Unit& u, int wr, int wc, int fr, int fq) const {
    const int row0 = u.pm * BM + wr * 64 + fr, col0 = u.pn * BM + wc * 32 + 8 * fq;
#pragma unroll
    for (int ai = 0; ai < 2; ++ai)
#pragma unroll
      for (int m = 0; m < 4; ++m) { const int row = row0 + ai * HALF + m * 16; const float s = rs[row]; bf16_t* rowp = O + (size_t)row * NQK + col0;
#pragma unroll
        for (int bj = 0; bj < 2; ++bj) { const f32x4 v0 = acc[ai][bj][m][0] * s, v1 = acc[ai][bj][m][1] * s;
          u32x4 w; w.x = cvt_pk_bf16(v0[0], v0[1]); w.y = cvt_pk_bf16(v0[2], v0[3]); w.z = cvt_pk_bf16(v1[0], v1[1]); w.w = cvt_pk_bf16(v1[2], v1[3]);
          *(u32x4*)(rowp + bj * HALF) = w; } }
  }
};
struct EpiVT {
  static constexpr bool PERM = true;
  bf16_t* O; const float* rs;
  __device__ __forceinline__ void operator()(AccT acc, const Unit& u, int wr, int wc, int fr, int fq) const {
    const int row0 = u.pm * BM + wr * 64 + fr, tok0 = u.pn * BM + wc * 32 + 8 * fq;
    const int bb = u.pn >> 4, s0 = (u.pn & 15) * BM + wc * 32 + 8 * fq;
    f32x4 cs[2][2];
#pragma unroll
    for (int bj = 0; bj < 2; ++bj)
#pragma unroll
      for (int n = 0; n < 2; ++n) cs[bj][n] = *(const f32x4*)(rs + tok0 + bj * HALF + 4 * n);
#pragma unroll
    for (int ai = 0; ai < 2; ++ai)
#pragma unroll
      for (int m = 0; m < 4; ++m) { const int row = row0 + ai * HALF + m * 16; bf16_t* rowp = O + ((size_t)(bb * NV + row)) * S + s0;
#pragma unroll
        for (int bj = 0; bj < 2; ++bj) { const f32x4 v0 = acc[ai][bj][m][0] * cs[bj][0], v1 = acc[ai][bj][m][1] * cs[bj][1];
          u32x4 w; w.x = cvt_pk_bf16(v0[0], v0[1]); w.y = cvt_pk_bf16(v0[2], v0[3]); w.z = cvt_pk_bf16(v1[0], v1[1]); w.w = cvt_pk_bf16(v1[2], v1[3]);
          *(u32x4*)(rowp + bj * HALF) = w; } }
  }
};
struct EpiH {
  static constexpr bool PERM = false;
  float* H; bf16_t* Hb; const float* X;
  __device__ __forceinline__ void operator()(AccT acc, const Unit& u, int wr, int wc, int fr, int fq) const {
    const int row0 = u.pm * BM + wr * 64 + fr, col0 = u.pn * BM + wc * 32 + 4 * fq;
#pragma unroll
    for (int ai = 0; ai < 2; ++ai)
#pragma unroll
      for (int m = 0; m < 4; ++m) { const size_t off = (size_t)(row0 + ai * HALF + m * 16) * D + col0;
#pragma unroll
        for (int bj = 0; bj < 2; ++bj)
#pragma unroll
          for (int n = 0; n < 2; ++n) { const size_t o = off + bj * HALF + n * 16; const f32x4 hv = *(const f32x4*)(X + o) + acc[ai][bj][m][n];
            *(f32x4*)(H + o) = hv; u32x2 w; w.x = cvt_pk_bf16(hv[0], hv[1]); w.y = cvt_pk_bf16(hv[2], hv[3]); *(u32x2*)(Hb + o) = w; } }
  }
};
__device__ __forceinline__ float silu_mul(float g, float u) { return g * __builtin_amdgcn_rcpf(1.0f + __builtin_amdgcn_exp2f(-g * LOG2E)) * u; }
struct EpiMoe1 {
  static constexpr bool PERM = true;
  bf16_t* Hid; const float* rsel;
  __device__ __forceinline__ void operator()(AccT acc, const Unit& u, int wr, int wc, int fr, int fq) const {
    const int row0 = u.pm * BM + wr * 64 + fr, col0 = u.pn * HALF + wc * 32 + 8 * fq;
#pragma unroll
    for (int ai = 0; ai < 2; ++ai)
#pragma unroll
      for (int m = 0; m < 4; ++m) { const int row = row0 + ai * HALF + m * 16; const float s = rsel[row];
        const f32x4 g0 = acc[ai][0][m][0] * s, g1 = acc[ai][0][m][1] * s, u0 = acc[ai][1][m][0] * s, u1 = acc[ai][1][m][1] * s;
        u32x4 w; w.x = cvt_pk_bf16(silu_mul(g0[0], u0[0]), silu_mul(g0[1], u0[1])); w.y = cvt_pk_bf16(silu_mul(g0[2], u0[2]), silu_mul(g0[3], u0[3]));
        w.z = cvt_pk_bf16(silu_mul(g1[0], u1[0]), silu_mul(g1[1], u1[1])); w.w = cvt_pk_bf16(silu_mul(g1[2], u1[2]), silu_mul(g1[3], u1[3]));
        *(u32x4*)(Hid + (size_t)row * FF + col0) = w; }
  }
};
struct EpiRowScale {
  static constexpr bool PERM = true;
  bf16_t* O; const float* rs;
  __device__ __forceinline__ void operator()(AccT acc, const Unit& u, int wr, int wc, int fr, int fq) const {
    const int row0 = u.pm * BM + wr * 64 + fr, col0 = u.pn * BM + wc * 32 + 8 * fq;
#pragma unroll
    for (int ai = 0; ai < 2; ++ai)
#pragma unroll
      for (int m = 0; m < 4; ++m) { const int row = row0 + ai * HALF + m * 16; const float s = rs ? rs[row] : 1.0f; bf16_t* rowp = O + (size_t)row * D + col0;
#pragma unroll
        for (int bj = 0; bj < 2; ++bj) { const f32x4 v0 = acc[ai][bj][m][0] * s, v1 = acc[ai][bj][m][1] * s;
          u32x4 w; w.x = cvt_pk_bf16(v0[0], v0[1]); w.y = cvt_pk_bf16(v0[2], v0[3]); w.z = cvt_pk_bf16(v1[0], v1[1]); w.w = cvt_pk_bf16(v1[2], v1[3]);
          *(u32x4*)(rowp + bj * HALF) = w; } }
  }
};
struct EpiPle {
  static constexpr bool PERM = false;
  float* H; const bf16_t* PP; const float* r3; float* ssq;
  __device__ __forceinline__ void operator()(AccT acc, const Unit& u, int wr, int wc, int fr, int fq) const {
    const int row0 = u.pm * BM + wr * 64 + fr, col0 = u.pn * BM + wc * 32 + 4 * fq;
#pragma unroll
    for (int ai = 0; ai < 2; ++ai)
#pragma unroll
      for (int m = 0; m < 4; ++m) { const int row = row0 + ai * HALF + m * 16; const size_t off = (size_t)row * D + col0; const float rr = r3[row] * LOG2E; float ss = 0.f;
#pragma unroll
        for (int bj = 0; bj < 2; ++bj)
#pragma unroll
          for (int n = 0; n < 2; ++n) { const size_t o = off + bj * HALF + n * 16; const f32x4 a = acc[ai][bj][m][n]; const f32x4 hv = *(const f32x4*)(H + o); const u32x2 pw = *(const u32x2*)(PP + o);
            f32x4 r; r[0] = hv[0] + __builtin_amdgcn_rcpf(1.0f + __builtin_amdgcn_exp2f(-a[0] * rr)) * bflo(pw.x); r[1] = hv[1] + __builtin_amdgcn_rcpf(1.0f + __builtin_amdgcn_exp2f(-a[1] * rr)) * bfhi(pw.x);
            r[2] = hv[2] + __builtin_amdgcn_rcpf(1.0f + __builtin_amdgcn_exp2f(-a[2] * rr)) * bflo(pw.y); r[3] = hv[3] + __builtin_amdgcn_rcpf(1.0f + __builtin_amdgcn_exp2f(-a[3] * rr)) * bfhi(pw.y);
            *(f32x4*)(H + o) = r; ss += (r[0] * r[0] + r[1] * r[1]) + (r[2] * r[2] + r[3] * r[3]); }
        ss += __shfl_xor(ss, 16); ss += __shfl_xor(ss, 32);
        if (fq == 0) atomicAdd(ssq + row, ss); }
  }
};
}

struct Args { const float* in[21]; float* out; unsigned char* ws; int ph_lo, ph_hi, bar_li, pad; };
struct Frame {
  LAS unsigned char* lds; int tid, lane, wave, vcu, G;
  const float *x, *p, *g_mix, *w_in, *rpb, *g_na, *lq1, *lk1, *lq2, *lk2, *g_df, *w_out, *g_moe, *w_router, *w_gate, *w_up, *w_down, *g_ple, *w_pg, *w_pp, *g_final;
  float* out; unsigned char* ws;
};
#define WSP(T_, off) ((T_*)(F.ws + (off)))

__device__ __forceinline__ void tr_item(const float* W, int ldw, int k0, int sc0, bf16_t* WT, size_t drow0, int Kd, int gmode, const float* g0, const float* g1, float cscale, LAS float* scr, int lane) {
#pragma unroll 8
  for (int i = 0; i < 32; ++i) { const int kk = 2 * i + (lane >> 5), k = k0 + kk;
    float gv = cscale;
    if (gmode == 1) gv *= g0[k]; else if (gmode == 2) gv *= (k < 512) ? g0[k] : 0.8f * g1[(k - 512) & 127];
    scr[kk * 33 + (lane & 31)] = W[(size_t)k * ldw + sc0 + (lane & 31)] * gv; }
  LDS_WAIT(); asm volatile("" ::: "memory");
  const int c = lane & 7;
#pragma unroll
  for (int j = 0; j < 4; ++j) { const int n = (lane >> 3) + 8 * j; const LAS float* s = scr + (8 * c) * 33 + n;
    u32x4 o; o.x = pk2(s[0 * 33], s[1 * 33]); o.y = pk2(s[2 * 33], s[3 * 33]); o.z = pk2(s[4 * 33], s[5 * 33]); o.w = pk2(s[6 * 33], s[7 * 33]);
    *(u32x4*)(WT + (drow0 + n) * Kd + k0 + 8 * c) = o; }
  LDS_WAIT(); asm volatile("" ::: "memory");
}
__device__ __forceinline__ void p0_prologue(Frame& F) {
  LAS float* scr = (LAS float*)(F.lds + F.wave * 16384);
  const int gw = F.vcu * 8 + F.wave, NGW = F.G * 8;
  constexpr int I_A = 512, I_B = 512, I_C = 256, I_D = 256, I_O = 512, I_PG = 512, I_PP = 128, I_EX = 8192;
  constexpr int NITEMS = I_A + I_B + I_C + I_D + I_O + I_PG + I_PP + 3 * I_EX;
  for (int it = gw; it < NITEMS; it += NGW) {
    int r = it;
    if (r < I_A) { const int kb = r / 32, nb = r % 32; tr_item(F.w_in, INW, kb * 64, nb * 32, WSP(bf16_t, WS_WQK), nb * 32, D, 1, F.g_mix, nullptr, nb < 16 ? QSCALE : 1.0f, scr, F.lane); continue; } r -= I_A;
    if (r < I_B) { const int kb = r / 32, nb = r % 32; tr_item(F.w_in, INW, kb * 64, 1536 + nb * 32, WSP(bf16_t, WS_WQK), 1024 + nb * 32, D, 1, F.g_mix, nullptr, nb < 16 ? QSCALE : 1.0f, scr, F.lane); continue; } r -= I_B;
    if (r < I_C) { const int kb = r / 16, nb = r % 16; tr_item(F.w_in, INW, kb * 64, 1024 + nb * 32, WSP(bf16_t, WS_WV), nb * 32, D, 1, F.g_mix, nullptr, 1.0f, scr, F.lane); continue; } r -= I_C;
    if (r < I_D) { const int kb = r / 16, nb = r % 16; tr_item(F.w_in, INW, kb * 64, 2560 + nb * 32, WSP(bf16_t, WS_WV), 512 + nb * 32, D, 1, F.g_mix, nullptr, 1.0f, scr, F.lane); continue; } r -= I_D;
    if (r < I_O) { const int kb = r / 32, nb = r % 32; tr_item(F.w_out, D, kb * 64, nb * 32, WSP(bf16_t, WS_WOUT), nb * 32, D, 2, F.g_na, F.g_df, 1.0f, scr, F.lane); continue; } r -= I_O;
    if (r < I_PG) { const int kb = r / 32, nb = r % 32; tr_item(F.w_pg, D, kb * 64, nb * 32, WSP(bf16_t, WS_WPG), nb * 32, D, 1, F.g_ple, nullptr, 1.0f, scr, F.lane); continue; } r -= I_PG;
    if (r < I_PP) { const int kb = r / 32, nb = r % 32; tr_item(F.w_pp, D, kb * 64, nb * 32, WSP(bf16_t, WS_WPP), nb * 32, PLE, 0, nullptr, nullptr, 1.0f, scr, F.lane); continue; } r -= I_PP;
    if (r < 2 * I_EX) { const int up = r / I_EX; r %= I_EX; const int e = r / 512, q = r % 512, kb = q / 32, nb = q % 32, f0 = nb * 32;
      tr_item((up ? F.w_up : F.w_gate) + (size_t)e * D * FF, FF, kb * 64, f0, WSP(bf16_t, WS_WGU), (size_t)e * 2048 + (f0 >> 7) * 256 + up * 128 + (f0 & 127), D, 1, F.g_moe, nullptr, 1.0f, scr, F.lane); continue; } r -= 2 * I_EX;
    { const int e = r / 512, q = r % 512, kb = q / 32, nb = q % 32;
      tr_item(F.w_down + (size_t)e * FF * D, D, kb * 64, nb * 32, WSP(bf16_t, WS_WDN), (size_t)e * 1024 + nb * 32, FF, 0, nullptr, nullptr, 1.0f, scr, F.lane); }
  }
  float* r1 = WSP(float, WS_R1); bf16_t* xb = WSP(bf16_t, WS_XB);
  for (int m = gw; m < T; m += NGW) {
    const f32x4* xr = (const f32x4*)(F.x + (size_t)m * D) + F.lane; f32x4 v[4]; float s = 0.f;
#pragma unroll
    for (int j = 0; j < 4; ++j) { v[j] = xr[64 * j]; s += (v[j].x * v[j].x + v[j].y * v[j].y) + (v[j].z * v[j].z + v[j].w * v[j].w); }
    s = wave_sum(s);
    if (F.lane == 0) r1[m] = rsqrtf(s * (1.0f / D) + EPS);
    u32x2* o8 = (u32x2*)(xb + (size_t)m * D) + F.lane;
#pragma unroll
    for (int j = 0; j < 4; ++j) { u32x2 w; w.x = pk2(v[j].x, v[j].y); w.y = pk2(v[j].z, v[j].w); o8[64 * j] = w; }
  }
  { const f32x4* ps = (const f32x4*)F.p; u32x2* pd = WSP(u32x2, WS_PB); const int n4 = T * PLE / 4;
    for (int i = F.vcu * 512 + F.tid; i < n4; i += F.G * 512) { const f32x4 v = ps[i]; u32x2 w; w.x = pk2(v.x, v.y); w.y = pk2(v.z, v.w); pd[i] = w; } }
}

constexpr int ABUF = 32768;
constexpr int RPB_OFF = 2 * ABUF;
template <int MODE>
__device__ __forceinline__ void attn_unit(Frame& F, int b, int h, int qblk, float lam) {
  constexpr int NC = MODE ? 1 : 2, DV = MODE ? 64 : 128, NDB = DV / 32, QPU = MODE ? 256 : 128;
  const int tid = F.tid, lane = F.lane, wid = F.wave, q = lane & 31, hh = lane >> 5;
  const int cw = MODE ? 0 : (wid & 1), qg = MODE ? wid : (wid >> 1);
  const bf16_t* QK = WSP(const bf16_t, WS_QK); const bf16_t* VT = WSP(const bf16_t, WS_VT); bf16_t* ON = WSP(bf16_t, WS_XB);
  const int qcol = MODE ? h * 64 : 1024 + h * 128, kcol = MODE ? 512 + h * 64 : 1536 + h * 128, vrow0 = MODE ? h * 64 : 512 + h * 128;
  const size_t tb = (size_t)b * S;
  const int s_q = qblk * QPU + qg * 32 + q;
  const int gr = qblk * 4 + (wid >> 1), qc = (wid & 1) * 32 + q;
  const int rs_w = min(max(gr - 4, 0), ROWS - 8);
  const int cs_q = min(max(qc - 8, 0), GW - 16);
  int kr0, NT;
  if (MODE) { const int r0 = qblk * 4; kr0 = min(max(r0 - 4, 0), ROWS - 8); const int r3 = r0 + 3; NT = min(max(r3 - 4, 0), ROWS - 8) + 8 - kr0; }
  else { kr0 = 0; NT = S / 64; }
  LAS float* rpbL = (LAS float*)(F.lds + RPB_OFF);
  __syncthreads();
  if (MODE) { if (tid < 480) { const int dr = tid >> 5, dc = tid & 31; rpbL[tid] = (dc < 31) ? F.rpb[(h * 15 + dr) * 31 + dc] * LOG2E : 0.f; } }
  const int srow = wid * 8 + (lane >> 3), sslot = lane & 7;
  const bf16_t* kg = QK + (tb + (size_t)kr0 * 64 + srow) * NQK + kcol + ((sslot ^ ((srow >> 1) & 7)) * 8);
  const bf16_t* vg = VT + ((size_t)b * NV + vrow0 + srow) * S + (size_t)kr0 * 64 + ((sslot ^ ((srow >> 1) & 7)) * 8);
#define ATT_STAGE(t, buf) do { LAS unsigned char* bp_ = F.lds + (buf) * ABUF + wid * 1024; \
    _Pragma("unroll") for (int c = 0; c < NC; ++c) __builtin_amdgcn_global_load_lds((const unsigned*)(kg + (size_t)(t) * 64 * NQK + c * 64), (LAS unsigned*)(bp_ + c * 8192), 16, 0, 0); \
    _Pragma("unroll") for (int j = 0; j < DV / 64; ++j) __builtin_amdgcn_global_load_lds((const unsigned*)(vg + (size_t)j * 64 * S + (size_t)(t) * 64), (LAS unsigned*)(bp_ + 16384 + j * 8192), 16, 0, 0); } while (0)
  ATT_STAGE(0, 0);
  bf16x8 Qf[4];
  { const bf16_t* qp = QK + (tb + s_q) * NQK + qcol + cw * 64 + hh * 8;
#pragma unroll
    for (int st = 0; st < 4; ++st) Qf[st] = *(const bf16x8*)(qp + st * 16); }
  f32x16 O[NDB]; float mrun = -INFINITY, lrun = 0.f;
#pragma unroll
  for (int db = 0; db < NDB; ++db)
#pragma unroll
    for (int r = 0; r < 16; ++r) O[db][r] = 0.f;
  const int prow = (q & 0x13) | ((q & 4) << 1) | ((q & 8) >> 1);
  int kad[4], vad[4];
#pragma unroll
  for (int i = 0; i < 4; ++i) { kad[i] = cw * 8192 + prow * 128 + (((2 * i + hh) ^ ((prow >> 1) & 7)) << 4); vad[i] = 16384 + q * 128 + (((2 * i + hh) ^ ((q >> 1) & 7)) << 4); }
  const float sl2 = MODE ? 0.f : exp2f(-2.0f * (float)(h + 1)) * LOG2E;
  const float fq_pos = (float)s_q;
  asm volatile("s_waitcnt vmcnt(0)" ::: "memory");
  __syncthreads();
  for (int t = 0; t < NT; ++t) {
    if (t + 1 < NT) ATT_STAGE(t + 1, (t + 1) & 1);
    const LAS unsigned char* bp = F.lds + (t & 1) * ABUF;
    const int krow = kr0 + t;
    const bool active = MODE ? (krow >= rs_w && krow < rs_w + 8) : true;
    if (active) {
      f32x16 s0, s1;
#pragma unroll
      for (int r = 0; r < 16; ++r) { s0[r] = 0.f; s1[r] = 0.f; }
#pragma unroll
      for (int st = 0; st < 4; ++st) {
        const bf16x8 k0 = *(const LAS bf16x8*)(bp + kad[st]), k1 = *(const LAS bf16x8*)(bp + 4096 + kad[st]);
        s0 = __builtin_amdgcn_mfma_f32_32x32x16_bf16(k0, Qf[st], s0, 0, 0, 0);
        s1 = __builtin_amdgcn_mfma_f32_32x32x16_bf16(k1, Qf[st], s1, 0, 0, 0);
      }
      if (MODE) {
        const LAS float* rp = rpbL + (krow - gr + 7) * 32 - qc + 15;
#pragma unroll
        for (int r = 0; r < 16; ++r) { const int kc0 = 16 * (r >> 3) + 8 * hh + (r & 7), kc1 = kc0 + 32;
          s0[r] = (kc0 >= cs_q && kc0 < cs_q + 16) ? s0[r] + rp[kc0] : -INFINITY;
          s1[r] = (kc1 >= cs_q && kc1 < cs_q + 16) ? s1[r] + rp[kc1] : -INFINITY; }
      } else {
        const float d0 = fq_pos - (float)(t * 64 + 8 * hh);
#pragma unroll
        for (int r = 0; r < 16; ++r) { const float dd = d0 - (float)(16 * (r >> 3) + (r & 7));
          s0[r] = __builtin_fmaf(-sl2, __builtin_fabsf(dd), s0[r]); s1[r] = __builtin_fmaf(-sl2, __builtin_fabsf(dd - 32.0f), s1[r]); }
      }
      float mx = s0[0];
#pragma unroll
      for (int r = 1; r < 16; ++r) mx = fmaxf(mx, s0[r]);
#pragma unroll
      for (int r = 0; r < 16; ++r) mx = fmaxf(mx, s1[r]);
      mx = fmaxf(mx, __shfl_xor(mx, 32));
      const float mnew = fmaxf(mrun, mx);
      const float alpha = __builtin_amdgcn_exp2f(mrun - mnew);
      mrun = mnew;
      if (__any(alpha != 1.0f)) {
        lrun *= alpha;
#pragma unroll
        for (int db = 0; db < NDB; ++db)
#pragma unroll
          for (int r = 0; r < 16; ++r) O[db][r] *= alpha;
      }
      float ls = 0.f;
#pragma unroll
      for (int r = 0; r < 16; ++r) { s0[r] = __builtin_amdgcn_exp2f(s0[r] - mnew); s1[r] = __builtin_amdgcn_exp2f(s1[r] - mnew); ls += s0[r] + s1[r]; }
      lrun += ls;
#pragma unroll
      for (int kb = 0; kb < 2; ++kb)
#pragma unroll
        for (int sx = 0; sx < 2; ++sx) {
          u32x4 pw;
          if (kb == 0) { pw.x = pg8::cvt_pk_bf16(s0[8 * sx + 0], s0[8 * sx + 1]); pw.y = pg8::cvt_pk_bf16(s0[8 * sx + 2], s0[8 * sx + 3]); pw.z = pg8::cvt_pk_bf16(s0[8 * sx + 4], s0[8 * sx + 5]); pw.w = pg8::cvt_pk_bf16(s0[8 * sx + 6], s0[8 * sx + 7]); }
          else { pw.x = pg8::cvt_pk_bf16(s1[8 * sx + 0], s1[8 * sx + 1]); pw.y = pg8::cvt_pk_bf16(s1[8 * sx + 2], s1[8 * sx + 3]); pw.z = pg8::cvt_pk_bf16(s1[8 * sx + 4], s1[8 * sx + 5]); pw.w = pg8::cvt_pk_bf16(s1[8 * sx + 6], s1[8 * sx + 7]); }
          const bf16x8 pf = __builtin_bit_cast(bf16x8, pw);
#pragma unroll
          for (int db = 0; db < NDB; ++db) {
            const bf16x8 vf = *(const LAS bf16x8*)(bp + db * 4096 + vad[kb * 2 + sx]);
            O[db] = __builtin_amdgcn_mfma_f32_32x32x16_bf16(vf, pf, O[db], 0, 0, 0);
          }
        }
    }
    asm volatile("s_waitcnt vmcnt(0)" ::: "memory");
    __syncthreads();
  }
#undef ATT_STAGE
  float lt = lrun; lt += __shfl_xor(lt, 32);
  const float inv = 1.0f / lt;
  if (!MODE) {
    LAS float* xch = (LAS float*)F.lds + (size_t)qg * 64 * 64 + lane;
    if (cw == 1) {
      const float sc = inv * lam;
#pragma unroll
      for (int db = 0; db < NDB; ++db)
#pragma unroll
        for (int r = 0; r < 16; ++r) xch[(db * 16 + r) * 64] = O[db][r] * sc;
    }
    __syncthreads();
    if (cw == 1) return;
#pragma unroll
    for (int db = 0; db < NDB; ++db)
#pragma unroll
      for (int r = 0; r < 16; ++r) O[db][r] = O[db][r] * inv - xch[(db * 16 + r) * 64];
  } else {
#pragma unroll
    for (int db = 0; db < NDB; ++db)
#pragma unroll
      for (int r = 0; r < 16; ++r) O[db][r] *= inv;
  }
  float ss = 0.f;
#pragma unroll
  for (int db = 0; db < NDB; ++db)
#pragma unroll
    for (int r = 0; r < 16; ++r) ss += O[db][r] * O[db][r];
  ss += __shfl_xor(ss, 32);
  const float rn = rsqrtf(ss * (1.0f / DV) + EPS);
  bf16_t* op = ON + (tb + s_q) * D + (MODE ? h * 64 : 512 + h * 128) + 4 * hh;
#pragma unroll
  for (int db = 0; db < NDB; ++db)
#pragma unroll
    for (int g4 = 0; g4 < 4; ++g4) { u32x2 w; w.x = pg8::cvt_pk_bf16(O[db][4 * g4 + 0] * rn, O[db][4 * g4 + 1] * rn); w.y = pg8::cvt_pk_bf16(O[db][4 * g4 + 2] * rn, O[db][4 * g4 + 3] * rn);
      *(u32x2*)(op + db * 32 + g4 * 8) = w; }
}
__device__ __forceinline__ void p2_attention(Frame& F, int p2sel) {
  const float lam = lam_value(F.lq1, F.lk1, F.lq2, F.lk2);
  constexpr int NDIFF = B * DFH * 32, NNA = B * NAH * 16;
  for (int L = F.vcu; L < NDIFF + NNA; L += F.G) {
    if (L >= NNA) { if (p2sel & 1) { const int l2 = L - NNA, qb = l2 & 31, bh = l2 >> 5; attn_unit<0>(F, bh >> 2, bh & 3, qb, lam); } }
    else { if (p2sel & 2) { const int qb = L & 15, bh = L >> 4; attn_unit<1>(F, bh >> 3, bh & 7, qb, lam); } }
  }
}

__device__ __forceinline__ void p4_router(Frame& F) {
  LAS float* wl = (LAS float*)F.lds;
  __syncthreads();
  for (int i = F.tid; i < D * E; i += 512) { const int k = i >> 4, e = i & 15; wl[e * D + k] = F.w_router[i] * F.g_moe[k]; }
  __syncthreads();
  const float* H = F.out; float* aff = WSP(float, WS_AFF); float* r2 = WSP(float, WS_R2);
  const int gw = F.vcu * 8 + F.wave, NGW = F.G * 8, lane = F.lane;
  for (int m = gw; m < T; m += NGW) {
    const f32x4* hr = (const f32x4*)(H + (size_t)m * D) + lane; f32x4 v[4]; float ss = 0.f;
#pragma unroll
    for (int j = 0; j < 4; ++j) { v[j] = hr[64 * j]; ss += (v[j].x * v[j].x + v[j].y * v[j].y) + (v[j].z * v[j].z + v[j].w * v[j].w); }
    float lg[E];
#pragma unroll
    for (int e = 0; e < E; ++e) { float a = 0.f;
#pragma unroll
      for (int j = 0; j < 4; ++j) { const f32x4 w = *(const LAS f32x4*)(wl + e * D + 4 * lane + 256 * j); a += (v[j].x * w.x + v[j].y * w.y) + (v[j].z * w.z + v[j].w * w.w); }
      lg[e] = a; if ((e & 3) == 3) asm volatile("" ::: "memory"); }
    ss = wave_sum(ss);
    const float rn = rsqrtf(ss * (1.0f / D) + EPS);
    float a8[8], a4[4], a2[2], a1;
    { const bool up = (lane & 32) != 0;
#pragma unroll
      for (int e = 0; e < 8; ++e) { const float snd = up ? lg[e] : lg[e + 8], kp = up ? lg[e + 8] : lg[e]; a8[e] = kp + __shfl_xor(snd, 32); } }
    { const bool up = (lane & 16) != 0;
#pragma unroll
      for (int e = 0; e < 4; ++e) { const float snd = up ? a8[e] : a8[e + 4], kp = up ? a8[e + 4] : a8[e]; a4[e] = kp + __shfl_xor(snd, 16); } }
    { const bool up = (lane & 8) != 0;
#pragma unroll
      for (int e = 0; e < 2; ++e) { const float snd = up ? a4[e] : a4[e + 2], kp = up ? a4[e + 2] : a4[e]; a2[e] = kp + __shfl_xor(snd, 8); } }
    { const bool up = (lane & 4) != 0; const float snd = up ? a2[0] : a2[1], kp = up ? a2[1] : a2[0]; a1 = kp + __shfl_xor(snd, 4); }
    a1 += __shfl_xor(a1, 2); a1 += __shfl_xor(a1, 1);
    const float logit = a1 * rn;
    float mx = logit;
    mx = fmaxf(mx, __shfl_xor(mx, 4)); mx = fmaxf(mx, __shfl_xor(mx, 8)); mx = fmaxf(mx, __shfl_xor(mx, 16)); mx = fmaxf(mx, __shfl_xor(mx, 32));
    const float ex = expf(logit - mx);
    float den = ex;
    den += __shfl_xor(den, 4); den += __shfl_xor(den, 8); den += __shfl_xor(den, 16); den += __shfl_xor(den, 32);
    const int e = ((lane >> 5) & 1) * 8 + ((lane >> 4) & 1) * 4 + ((lane >> 3) & 1) * 2 + ((lane >> 2) & 1);
    const int b = m / S, s = m % S;
    if ((lane & 3) == 0) aff[((size_t)b * E + e) * S + s] = ex / den;
    if (lane == 0) r2[m] = rn;
  }
}

__device__ __forceinline__ void p5_topk(Frame& F) {
  LAS unsigned long long* key = (LAS unsigned long long*)F.lds;
  const float* aff = WSP(const float, WS_AFF); const float* r2 = WSP(const float, WS_R2);
  int* tok = WSP(int, WS_TOK); float* gsel = WSP(float, WS_GSEL); float* rsel = WSP(float, WS_RSEL); int* inv = WSP(int, WS_INV);
  for (int be = F.vcu; be < B * E; be += F.G) {
    const int b = be / E, e = be % E;
    __syncthreads();
    for (int i = F.tid; i < S; i += 512) { const unsigned bits = __builtin_bit_cast(unsigned, __hip_atomic_load(aff + (size_t)be * S + i, RLX_AGENT)); key[i] = ((unsigned long long)bits << 32) | (unsigned)(S - 1 - i); }
    __syncthreads();
    for (int k = 2; k <= S; k <<= 1)
      for (int j = k >> 1; j > 0; j >>= 1) {
        for (int p = F.tid; p < S / 2; p += 512) {
          const int i = ((p & ~(j - 1)) << 1) | (p & (j - 1)), ixj = i | j;
          const unsigned long long a = key[i], c = key[ixj];
          const bool desc = ((i & k) == 0);
          if (desc ? (a < c) : (a > c)) { key[i] = c; key[ixj] = a; }
        }
        __syncthreads();
      }
    for (int r = F.tid; r < S; r += 512) {
      const unsigned long long kv = key[r]; const int i = S - 1 - (int)(unsigned)(kv & 0xffffffffu);
      const int t = b * S + i;
      if (r < CAP) { const int row = be * CAP + r; tok[row] = t; gsel[row] = __builtin_bit_cast(float, (unsigned)(kv >> 32)); rsel[row] = __hip_atomic_load(r2 + t, RLX_AGENT); inv[(size_t)t * E + e] = r; }
      else inv[(size_t)t * E + e] = -1;
    }
  }
}

__device__ __forceinline__ void p8_combine(Frame& F) {
  float* H = F.out; const bf16_t* Y = WSP(const bf16_t, WS_VT); bf16_t* H2b = WSP(bf16_t, WS_XB); float* r3 = WSP(float, WS_R3); const int* inv = WSP(const int, WS_INV);
  const int gw = F.vcu * 8 + F.wave, NGW = F.G * 8, lane = F.lane;
  for (int m = gw; m < T; m += NGW) {
    const int b = m / S;
    const int iv = (lane < E) ? __hip_atomic_load(inv + (size_t)m * E + lane, RLX_AGENT) : -1;
    f32x4 a[4];
    float* hp = H + (size_t)m * D + 8 * lane;
    a[0] = *(const f32x4*)(hp); a[1] = *(const f32x4*)(hp + 4); a[2] = *(const f32x4*)(hp + 512); a[3] = *(const f32x4*)(hp + 516);
#pragma unroll
    for (int e = 0; e < E; ++e) {
      const int c = __builtin_amdgcn_readlane(iv, e);
      if (c >= 0) {
        const bf16_t* yp = Y + ((size_t)(b * E + e) * CAP + c) * D + 8 * lane;
        const u32x4 y0 = *(const u32x4*)yp, y1 = *(const u32x4*)(yp + 512);
        a[0].x += bflo(y0.x); a[0].y += bfhi(y0.x); a[0].z += bflo(y0.y); a[0].w += bfhi(y0.y); a[1].x += bflo(y0.z); a[1].y += bfhi(y0.z); a[1].z += bflo(y0.w); a[1].w += bfhi(y0.w);
        a[2].x += bflo(y1.x); a[2].y += bfhi(y1.x); a[2].z += bflo(y1.y); a[2].w += bfhi(y1.y); a[3].x += bflo(y1.z); a[3].y += bfhi(y1.z); a[3].z += bflo(y1.w); a[3].w += bfhi(y1.w);
      }
    }
    float ss = 0.f;
#pragma unroll
    for (int j = 0; j < 4; ++j) ss += (a[j].x * a[j].x + a[j].y * a[j].y) + (a[j].z * a[j].z + a[j].w * a[j].w);
    ss = wave_sum(ss);
    *(f32x4*)(hp) = a[0]; *(f32x4*)(hp + 4) = a[1]; *(f32x4*)(hp + 512) = a[2]; *(f32x4*)(hp + 516) = a[3];
    bf16_t* bp = H2b + (size_t)m * D + 8 * lane;
    u32x4 w0, w1; w0.x = pk2(a[0].x, a[0].y); w0.y = pk2(a[0].z, a[0].w); w0.z = pk2(a[1].x, a[1].y); w0.w = pk2(a[1].z, a[1].w);
    w1.x = pk2(a[2].x, a[2].y); w1.y = pk2(a[2].z, a[2].w); w1.z = pk2(a[3].x, a[3].y); w1.w = pk2(a[3].z, a[3].w);
    *(u32x4*)bp = w0; *(u32x4*)(bp + 512) = w1;
    if (lane == 0) r3[m] = rsqrtf(ss * (1.0f / D) + EPS);
  }
}

__device__ __forceinline__ void p10_final(Frame& F) {
  float* H = F.out; const float* ssq = WSP(const float, WS_SSQ);
  const int gw = F.vcu * 8 + F.wave, NGW = F.G * 8, lane = F.lane;
  f32x4 g[4];
#pragma unroll
  for (int j = 0; j < 4; ++j) g[j] = ((const f32x4*)F.g_final)[lane + 64 * j];
  for (int m = gw; m < T; m += NGW) {
    const float rn = rsqrtf(__hip_atomic_load(ssq + m, RLX_AGENT) * (1.0f / D) + EPS);
    f32x4* hr = (f32x4*)(H + (size_t)m * D) + lane;
#pragma unroll
    for (int j = 0; j < 4; ++j) { f32x4 v = hr[64 * j]; v = v * rn * g[j]; hr[64 * j] = v; }
  }
}

__global__ void __launch_bounds__(512, 2) mega_fwd(Args args) {
  extern __shared__ __attribute__((aligned(16))) unsigned char lds_raw[];
  Frame F;
  F.lds = (LAS unsigned char*)lds_raw;
  F.tid = threadIdx.x; F.lane = F.tid & 63; F.wave = __builtin_amdgcn_readfirstlane(F.tid >> 6);
  F.G = gridDim.x; { const int bx = blockIdx.x; F.vcu = (F.G % 8 == 0) ? (bx % 8) * (F.G / 8) + bx / 8 : bx; }
  F.x = args.in[0]; F.p = args.in[1]; F.g_mix = args.in[2]; F.w_in = args.in[3]; F.rpb = args.in[4]; F.g_na = args.in[5];
  F.lq1 = args.in[6]; F.lk1 = args.in[7]; F.lq2 = args.in[8]; F.lk2 = args.in[9]; F.g_df = args.in[10]; F.w_out = args.in[11]; F.g_moe = args.in[12];
  F.w_router = args.in[13]; F.w_gate = args.in[14]; F.w_up = args.in[15]; F.w_down = args.in[16]; F.g_ple = args.in[17]; F.w_pg = args.in[18]; F.w_pp = args.in[19]; F.g_final = args.in[20];
  F.out = args.out; F.ws = args.ws;
  volatile LAS unsigned* MISC = (volatile LAS unsigned*)(F.lds + MISC_OFF);
  for (int u = F.tid; u < (LDS_BYTES - MISC_OFF) / 4; u += 512) MISC[u] = 0u;
  __syncthreads();
  const int lo = args.ph_lo, hi = args.ph_hi;
  const bool multi = (hi - lo) > 1;
  unsigned* barw = (unsigned*)(F.ws + WS_CTL) + CW_BAR + args.bar_li * 4096;
  XcdBarrier bar; bar.bar = barw; bar.x = 0; bar.st = nullptr;
  if (multi) bar = xcd_barrier_post(barw, MISC + 8);
#ifndef PH_MASK
#define PH_MASK 0x7FF
#endif
#define IN(k) ((((PH_MASK) >> (k)) & 1) && lo <= (k) && (k) < hi)
#define SEAM(k) do { if (IN(k) && IN((k) + 1)) xcd_barrier(bar); } while (0)
  const LAS int* tokL = (const LAS int*)(F.lds + TOKL_OFF);

  if (IN(0)) { p0_prologue(F); } SEAM(0);

  if (IN(1)) {
    { pg8::OrderStd S_; S_.init(T, NQK, D, F.G, (int)blockIdx.x); pg8::EpiQK E_{WSP(bf16_t, WS_QK), WSP(const float, WS_R1)};
      pg8::gemm_phase<pg8::EpiQK, pg8::OrderStd, true, false>(F.lds, (const char*)(F.ws + WS_XB), (const char*)(F.ws + WS_WQK), D, S_, E_, tokL); }
    { pg8::OrderStd S_; S_.init(NV, T, D, F.G, (int)blockIdx.x); pg8::EpiVT E_{WSP(bf16_t, WS_VT), WSP(const float, WS_R1)};
      pg8::gemm_phase<pg8::EpiVT, pg8::OrderStd, true, false>(F.lds, (const char*)(F.ws + WS_WV), (const char*)(F.ws + WS_XB), D, S_, E_, tokL); }
  } SEAM(1);

  if (IN(2)) { p2_attention(F, args.pad); } SEAM(2);

  if (IN(3)) {
    pg8::OrderStd S_; S_.init(T, D, D, F.G, (int)blockIdx.x); pg8::EpiH E_{F.out, WSP(bf16_t, WS_VT), F.x};
    pg8::gemm_phase<pg8::EpiH, pg8::OrderStd, true, false>(F.lds, (const char*)(F.ws + WS_XB), (const char*)(F.ws + WS_WOUT), D, S_, E_, tokL);
  } SEAM(3);

  if (IN(4)) { p4_router(F); } SEAM(4);
  if (IN(5)) { p5_topk(F); } SEAM(5);

  if (IN(6)) {
    pg8::OrderMoe S_; S_.G = F.G; S_.vcu = F.vcu; S_.upe = 128; S_.npn = 8; S_.total = 2048; S_.tstepA = 0; S_.tstepB = (size_t)256 * D * 2; S_.estepB = (size_t)2048 * D * 2;
    { LAS int* tl = (LAS int*)(F.lds + TOKL_OFF); const int* tok = WSP(const int, WS_TOK); pg8::Unit u;
      for (int i = 0; i < 8 && S_.next(i, u); ++i) for (int r = F.tid; r < 256; r += 512) tl[i * 256 + r] = __hip_atomic_load(tok + (size_t)u.pm * 256 + r, RLX_AGENT);
      __syncthreads(); }
    pg8::EpiMoe1 E_{WSP(bf16_t, WS_QK), WSP(const float, WS_RSEL)};
    pg8::gemm_phase<pg8::EpiMoe1, pg8::OrderMoe, true, true>(F.lds, (const char*)(F.ws + WS_VT), (const char*)(F.ws + WS_WGU), D, S_, E_, tokL);
  } SEAM(6);

  if (IN(7)) {
    pg8::OrderMoe S_; S_.G = F.G; S_.vcu = F.vcu; S_.upe = 64; S_.npn = 4; S_.total = 1024; S_.tstepA = (size_t)256 * FF * 2; S_.tstepB = (size_t)256 * FF * 2; S_.estepB = (size_t)1024 * FF * 2;
    pg8::EpiRowScale E_{WSP(bf16_t, WS_VT), WSP(const float, WS_GSEL)};
    pg8::gemm_phase<pg8::EpiRowScale, pg8::OrderMoe, true, false>(F.lds, (const char*)(F.ws + WS_QK), (const char*)(F.ws + WS_WDN), FF, S_, E_, tokL);
  } SEAM(7);

  if (IN(8)) {
    p8_combine(F);
    __syncthreads();
    int kpp = PLE; asm volatile("" : "+s"(kpp));
    pg8::OrderStd S_; S_.init(T, D, kpp, F.G, (int)blockIdx.x); pg8::EpiRowScale E_{WSP(bf16_t, WS_QK), nullptr};
    pg8::gemm_phase<pg8::EpiRowScale, pg8::OrderStd, true, false>(F.lds, (const char*)(F.ws + WS_PB), (const char*)(F.ws + WS_WPP), kpp, S_, E_, tokL);
  } SEAM(8);

  if (IN(9)) {
    pg8::OrderStd S_; S_.init(T, D, D, F.G, (int)blockIdx.x); pg8::EpiPle E_{F.out, WSP(const bf16_t, WS_QK), WSP(const float, WS_R3), WSP(float, WS_SSQ)};
    pg8::gemm_phase<pg8::EpiPle, pg8::OrderStd, true, false>(F.lds, (const char*)(F.ws + WS_XB), (const char*)(F.ws + WS_WPG), D, S_, E_, tokL);
  } SEAM(9);

  if (IN(10)) { p10_final(F); }
#undef IN
#undef SEAM
}

namespace nv {
template <class Epi>
__global__ void __launch_bounds__(256) k_gemm(const bf16_t* __restrict__ A, int lda, const int* __restrict__ rowidx, int rows_per_z, const bf16_t* __restrict__ Bt, int ldb, size_t bstride_z, int zdiv, int K, Epi epi) {
  __shared__ float As[16][68]; __shared__ float Bs[16][68];
  const int tid = threadIdx.x, tx = tid & 15, ty = tid >> 4, z = blockIdx.z, m0 = blockIdx.y * 64, n0 = blockIdx.x * 64;
  const bf16_t* Bz = Bt + (size_t)(z % zdiv) * bstride_z;
  const int lr = tid >> 2, lk = (tid & 3) * 4;
  const int grow = z * rows_per_z + m0 + lr; const long arow = rowidx ? (long)rowidx[grow] : (long)grow;
  const bf16_t* Ap = A + arow * lda; const bf16_t* Bp = Bz + (size_t)(n0 + lr) * ldb;
  float acc[4][4];
#pragma unroll
  for (int i = 0; i < 4; ++i)
#pragma unroll
    for (int j = 0; j < 4; ++j) acc[i][j] = 0.f;
  for (int k0 = 0; k0 < K; k0 += 16) {
#pragma unroll
    for (int i = 0; i < 4; ++i) { As[lk + i][lr] = bf2f(Ap[k0 + lk + i]); Bs[lk + i][lr] = bf2f(Bp[k0 + lk + i]); }
    __syncthreads();
#pragma unroll
    for (int kk = 0; kk < 16; ++kk) { const float4 av = *(const float4*)&As[kk][ty * 4], bv = *(const float4*)&Bs[kk][tx * 4];
      const float a4[4] = {av.x, av.y, av.z, av.w}, b4[4] = {bv.x, bv.y, bv.z, bv.w};
#pragma unroll
      for (int i = 0; i < 4; ++i)
#pragma unroll
        for (int j = 0; j < 4; ++j) acc[i][j] = fmaf(a4[i], b4[j], acc[i][j]); }
    __syncthreads();
  }
#pragma unroll
  for (int i = 0; i < 4; ++i)
#pragma unroll
    for (int j = 0; j < 4; ++j) epi(z * rows_per_z + m0 + ty * 4 + i, n0 + tx * 4 + j, acc[i][j]);
}
struct EQK { bf16_t* O; const float* r1; __device__ void operator()(int m, int n, float a) const { O[(size_t)m * NQK + n] = (bf16_t)f2bf(a * r1[m]); } };
struct EVT { bf16_t* O; const float* r1; __device__ void operator()(int m, int n, float a) const { const int b = m / S, s = m % S; O[((size_t)b * NV + n) * S + s] = (bf16_t)f2bf(a * r1[m]); } };
struct EH { float* H; bf16_t* Hb; const float* X; __device__ void operator()(int m, int n, float a) const { const float v = X[(size_t)m * D + n] + a; H[(size_t)m * D + n] = v; Hb[(size_t)m * D + n] = (bf16_t)f2bf(v); } };
struct EM1 { float* G; __device__ void operator()(int m, int n, float a) const { G[(size_t)m * 2048 + n] = a; } };
struct ERS { bf16_t* O; const float* rs; __device__ void operator()(int m, int n, float a) const { O[(size_t)m * D + n] = (bf16_t)f2bf(rs ? a * rs[m] : a); } };
struct EPL { float* H; const bf16_t* PP; const float* r3; float* ssq; __device__ void operator()(int m, int n, float a) const {
  const float g = 1.0f / (1.0f + expf(-(r3[m] * a))); const float v = H[(size_t)m * D + n] + g * bf2f(PP[(size_t)m * D + n]); H[(size_t)m * D + n] = v; atomicAdd(ssq + m, v * v); } };
__global__ void __launch_bounds__(256) k_moe1_post(const float* __restrict__ G, const float* __restrict__ rsel, bf16_t* __restrict__ hid, int row0, int nrows) {
  const size_t i = (size_t)blockIdx.x * 256 + threadIdx.x; if (i >= (size_t)nrows * FF) return;
  const int m = (int)(i / FF), f = (int)(i % FF); const float rs = rsel[row0 + m];
  const float g = G[(size_t)m * 2048 + (f >> 7) * 256 + (f & 127)] * rs, u = G[(size_t)m * 2048 + (f >> 7) * 256 + 128 + (f & 127)] * rs;
  hid[(size_t)(row0 + m) * FF + f] = (bf16_t)f2bf((g / (1.0f + expf(-g))) * u);
}
__global__ void __launch_bounds__(256) k_na(const bf16_t* __restrict__ QK, const bf16_t* __restrict__ VT, const float* __restrict__ rpb, bf16_t* __restrict__ ON) {
  const int gid = blockIdx.x * 256 + threadIdx.x; if (gid >= T * NAH) return;
  const int h = gid & 7, t = gid >> 3, b = t / S, s = t % S, r = s / GW, qc = s % GW;
  const int rs = min(max(r - 4, 0), ROWS - 8), cs = min(max(qc - 8, 0), GW - 16);
  float q[64]; const bf16_t* qp = QK + (size_t)t * NQK + h * 64;
#pragma unroll
  for (int d = 0; d < 64; ++d) q[d] = bf2f(qp[d]);
  float m = -INFINITY, l = 0.f, o[64];
#pragma unroll
  for (int d = 0; d < 64; ++d) o[d] = 0.f;
  for (int rr = 0; rr < 8; ++rr) for (int jj = 0; jj < 16; ++jj) {
    const int kc = cs + jj, sk = (rs + rr) * GW + kc; const bf16_t* kp = QK + ((size_t)b * S + sk) * NQK + 512 + h * 64;
    float sc = 0.f;
#pragma unroll
    for (int d = 0; d < 64; ++d) sc = fmaf(q[d], bf2f(kp[d]), sc);
    sc += rpb[(h * 15 + (rs + rr - r + 7)) * 31 + (kc - qc + 15)] * LOG2E;
    const float mn = fmaxf(m, sc), f = exp2f(m - mn), p = exp2f(sc - mn); l = l * f + p;
    const bf16_t* vp = VT + ((size_t)b * NV + h * 64) * S + sk;
#pragma unroll
    for (int d = 0; d < 64; ++d) o[d] = o[d] * f + p * bf2f(vp[(size_t)d * S]);
    m = mn; }
  const float inv = 1.0f / l; float ss = 0.f;
#pragma unroll
  for (int d = 0; d < 64; ++d) { o[d] *= inv; ss += o[d] * o[d]; }
  const float rn = rsqrtf(ss * (1.0f / 64) + EPS); bf16_t* op = ON + (size_t)t * D + h * 64;
#pragma unroll
  for (int d = 0; d < 64; ++d) op[d] = (bf16_t)f2bf(o[d] * rn);
}
__global__ void __launch_bounds__(256) k_diff(const bf16_t* __restrict__ QK, const bf16_t* __restrict__ VT, float* __restrict__ tmp, int b0) {
  int bid = blockIdx.x; const int qb = bid % (S / 256); bid /= (S / 256); const int vh = bid & 1; bid >>= 1; const int c = bid & 1; bid >>= 1; const int h = bid % DFH, bl = bid / DFH, b = b0 + bl;
  const int qi = qb * 256 + threadIdx.x; const size_t t = (size_t)b * S + qi, tl = (size_t)bl * S + qi;
  const float slope = exp2f(-2.0f * (h + 1)) * LOG2E;
  float q[64]; const bf16_t* qp = QK + t * NQK + 1024 + h * 128 + c * 64;
#pragma unroll
  for (int d = 0; d < 64; ++d) q[d] = bf2f(qp[d]);
  float m = -INFINITY, l = 0.f, o[64];
#pragma unroll
  for (int d = 0; d < 64; ++d) o[d] = 0.f;
  for (int j = 0; j < S; ++j) {
    const bf16_t* kp = QK + ((size_t)b * S + j) * NQK + 1536 + h * 128 + c * 64;
    float sc = 0.f;
#pragma unroll
    for (int d = 0; d < 64; ++d) sc = fmaf(q[d], bf2f(kp[d]), sc);
    sc -= slope * fabsf((float)(qi - j));
    const float mn = fmaxf(m, sc), f = exp2f(m - mn), p = exp2f(sc - mn); l = l * f + p;
    const bf16_t* vp = VT + ((size_t)b * NV + 512 + h * 128 + vh * 64) * S + j;
#pragma unroll
    for (int d = 0; d < 64; ++d) o[d] = o[d] * f + p * bf2f(vp[(size_t)d * S]);
    m = mn; }
  const float inv = 1.0f / l; float* op = tmp + ((tl * DFH + h) * 2 + c) * 128 + vh * 64;
#pragma unroll
  for (int d = 0; d < 64; ++d) op[d] = o[d] * inv;
}
__global__ void __launch_bounds__(256) k_diff_post(const float* __restrict__ tmp, const float* q1, const float* k1, const float* q2, const float* k2, bf16_t* __restrict__ ON, int b0) {
  const int w = (blockIdx.x * 256 + threadIdx.x) >> 6, lane = threadIdx.x & 63; if (w >= 4 * S * DFH) return;
  const int h = w % DFH, tl = w / DFH; const float lam = lam_value(q1, k1, q2, k2);
  const float* p0 = tmp + ((size_t)w * 2 + 0) * 128; const float* p1 = tmp + ((size_t)w * 2 + 1) * 128;
  const float a0 = p0[lane] - lam * p1[lane], a1 = p0[lane + 64] - lam * p1[lane + 64];
  const float ss = wave_sum(a0 * a0 + a1 * a1); const float rn = rsqrtf(ss * (1.0f / 128) + EPS);
  bf16_t* op = ON + ((size_t)b0 * S + tl) * D + 512 + h * 128; op[lane] = (bf16_t)f2bf(a0 * rn); op[lane + 64] = (bf16_t)f2bf(a1 * rn);
}
__global__ void __launch_bounds__(256) k_router(const float* __restrict__ h, const float* __restrict__ gmoe, const float* __restrict__ wr, float* __restrict__ aff, float* __restrict__ r2) {
  const int w = (blockIdx.x * 256 + threadIdx.x) >> 6, lane = threadIdx.x & 63; if (w >= T) return;
  const float* hr = h + (size_t)w * D; float ss = 0.f, lg[E];
#pragma unroll
  for (int e = 0; e < E; ++e) lg[e] = 0.f;
  for (int k = lane; k < D; k += 64) { const float v = hr[k]; ss += v * v; const float vg = v * gmoe[k]; const float* wp = wr + (size_t)k * E;
#pragma unroll
    for (int e = 0; e < E; ++e) lg[e] = fmaf(vg, wp[e], lg[e]); }
  ss = wave_sum(ss); const float rn = rsqrtf(ss * (1.0f / D) + EPS); float mx = -INFINITY;
#pragma unroll
  for (int e = 0; e < E; ++e) { lg[e] = wave_sum(lg[e]) * rn; mx = fmaxf(mx, lg[e]); }
  float den = 0.f;
#pragma unroll
  for (int e = 0; e < E; ++e) { lg[e] = expf(lg[e] - mx); den += lg[e]; }
  const int b = w / S, s = w % S;
  if (lane < E) { float v = 0.f;
#pragma unroll
    for (int e = 0; e < E; ++e) if (lane == e) v = lg[e];
    aff[((size_t)b * E + lane) * S + s] = v / den; }
  if (lane == 0) r2[w] = rn;
}
__global__ void __launch_bounds__(512) k_topk(const float* __restrict__ aff, const float* __restrict__ r2, int* __restrict__ tok, float* __restrict__ gsel, float* __restrict__ rsel, int* __restrict__ inv) {
  __shared__ float a[S]; const int be = blockIdx.x, b = be / E, e = be % E; const float* ap = aff + (size_t)be * S;
  for (int i = threadIdx.x; i < S; i += 512) a[i] = ap[i];
  __syncthreads();
  for (int i = threadIdx.x; i < S; i += 512) { const float v = a[i]; int rank = 0;
    for (int j = 0; j < S; ++j) { const float u = a[j]; rank += (u > v || (u == v && j < i)) ? 1 : 0; }
    const int t = b * S + i;
    if (rank < CAP) { const int row = be * CAP + rank; tok[row] = t; gsel[row] = v; rsel[row] = r2[t]; inv[(size_t)t * E + e] = rank; } else inv[(size_t)t * E + e] = -1; }
}
__global__ void __launch_bounds__(256) k_combine(float* __restrict__ H, const bf16_t* __restrict__ Y, const int* __restrict__ inv, bf16_t* __restrict__ H2b, float* __restrict__ r3) {
  const int w = (blockIdx.x * 256 + threadIdx.x) >> 6, lane = threadIdx.x & 63; if (w >= T) return;
  const int b = w / S; float ss = 0.f;
  for (int k = lane; k < D; k += 64) { float v = H[(size_t)w * D + k];
    for (int e = 0; e < E; ++e) { const int c = inv[(size_t)w * E + e]; if (c >= 0) v += bf2f(Y[((size_t)(b * E + e) * CAP + c) * D + k]); }
    H[(size_t)w * D + k] = v; H2b[(size_t)w * D + k] = (bf16_t)f2bf(v); ss += v * v; }
  ss = wave_sum(ss); if (lane == 0) r3[w] = rsqrtf(ss * (1.0f / D) + EPS);
}
__global__ void __launch_bounds__(256) k_final(float* __restrict__ H, const float* __restrict__ ssq, const float* __restrict__ g) {
  const int w = (blockIdx.x * 256 + threadIdx.x) >> 6, lane = threadIdx.x & 63; if (w >= T) return;
  const float rn = rsqrtf(ssq[w] * (1.0f / D) + EPS);
  for (int k = lane; k < D; k += 64) H[(size_t)w * D + k] = H[(size_t)w * D + k] * rn * g[k];
}
}

static void launch_naive(int ph, void* const* d_in, float* out, unsigned char* ws, hipStream_t st) {
  using namespace nv;
  auto W = [&](size_t off) { return ws + off; };
  const float* x = (const float*)d_in[0];
  switch (ph) {
    case 1:
      k_gemm<EQK><<<dim3(NQK / 64, T / 64, 1), 256, 0, st>>>((const bf16_t*)W(WS_XB), D, nullptr, 0, (const bf16_t*)W(WS_WQK), D, 0, 1, D, EQK{(bf16_t*)W(WS_QK), (const float*)W(WS_R1)});
      k_gemm<EVT><<<dim3(NV / 64, T / 64, 1), 256, 0, st>>>((const bf16_t*)W(WS_XB), D, nullptr, 0, (const bf16_t*)W(WS_WV), D, 0, 1, D, EVT{(bf16_t*)W(WS_VT), (const float*)W(WS_R1)});
      break;
    case 2:
      k_na<<<T * NAH / 256, 256, 0, st>>>((const bf16_t*)W(WS_QK), (const bf16_t*)W(WS_VT), (const float*)d_in[4], (bf16_t*)W(WS_XB));
      for (int half = 0; half < 2; ++half) {
        k_diff<<<4 * DFH * 2 * 2 * (S / 256), 256, 0, st>>>((const bf16_t*)W(WS_QK), (const bf16_t*)W(WS_VT), out, half * 4);
        k_diff_post<<<4 * S * DFH / 4, 256, 0, st>>>(out, (const float*)d_in[6], (const float*)d_in[7], (const float*)d_in[8], (const float*)d_in[9], (bf16_t*)W(WS_XB), half * 4);
      }
      break;
    case 21:
      k_na<<<T * NAH / 256, 256, 0, st>>>((const bf16_t*)W(WS_QK), (const bf16_t*)W(WS_VT), (const float*)d_in[4], (bf16_t*)W(WS_XB));
      break;
    case 22:
      for (int half = 0; half < 2; ++half) {
        k_diff<<<4 * DFH * 2 * 2 * (S / 256), 256, 0, st>>>((const bf16_t*)W(WS_QK), (const bf16_t*)W(WS_VT), out, half * 4);
        k_diff_post<<<4 * S * DFH / 4, 256, 0, st>>>(out, (const float*)d_in[6], (const float*)d_in[7], (const float*)d_in[8], (const float*)d_in[9], (bf16_t*)W(WS_XB), half * 4);
      }
      break;
    case 3:
      k_gemm<EH><<<dim3(D / 64, T / 64, 1), 256, 0, st>>>((const bf16_t*)W(WS_XB), D, nullptr, 0, (const bf16_t*)W(WS_WOUT), D, 0, 1, D, EH{out, (bf16_t*)W(WS_VT), x});
      break;
    case 4:
      k_router<<<T / 4, 256, 0, st>>>(out, (const float*)d_in[12], (const float*)d_in[13], (float*)W(WS_AFF), (float*)W(WS_R2));
      break;
    case 5:
      k_topk<<<B * E, 512, 0, st>>>((const float*)W(WS_AFF), (const float*)W(WS_R2), (int*)W(WS_TOK), (float*)W(WS_GSEL), (float*)W(WS_RSEL), (int*)W(WS_INV));
      break;
    case 6:
      for (int ch = 0; ch < 8; ++ch) {
        float* G = (float*)W(388 * MiB);
        k_gemm<EM1><<<dim3(2048 / 64, CAP / 64, 16), 256, 0, st>>>((const bf16_t*)W(WS_VT), D, (const int*)W(WS_TOK) + ch * 8192, CAP, (const bf16_t*)W(WS_WGU), D, (size_t)2048 * D, E, D, EM1{G});
        k_moe1_post<<<8192 * FF / 256, 256, 0, st>>>(G, (const float*)W(WS_RSEL), (bf16_t*)W(WS_QK), ch * 8192, 8192);
      }
      break;
    case 7:
      k_gemm<ERS><<<dim3(D / 64, CAP / 64, B * E), 256, 0, st>>>((const bf16_t*)W(WS_QK), FF, nullptr, CAP, (const bf16_t*)W(WS_WDN), FF, (size_t)1024 * FF, E, FF, ERS{(bf16_t*)W(WS_VT), (const float*)W(WS_GSEL)});
      break;
    case 8:
      k_combine<<<T / 4, 256, 0, st>>>(out, (const bf16_t*)W(WS_VT), (const int*)W(WS_INV), (bf16_t*)W(WS_XB), (float*)W(WS_R3));
      k_gemm<ERS><<<dim3(D / 64, T / 64, 1), 256, 0, st>>>((const bf16_t*)W(WS_PB), PLE, nullptr, 0, (const bf16_t*)W(WS_WPP), PLE, 0, 1, PLE, ERS{(bf16_t*)W(WS_QK), nullptr});
      break;
    case 9:
      k_gemm<EPL><<<dim3(D / 64, T / 64, 1), 256, 0, st>>>((const bf16_t*)W(WS_XB), D, nullptr, 0, (const bf16_t*)W(WS_WPG), D, 0, 1, D, EPL{out, (const bf16_t*)W(WS_QK), (const float*)W(WS_R3), (float*)W(WS_SSQ)});
      break;
    case 10:
      k_final<<<T / 4, 256, 0, st>>>(out, (const float*)W(WS_SSQ), (const float*)d_in[20]);
      break;
    default: break;
  }
}

extern "C" void kernel_launch(void* const* d_in, const int* in_sizes, int n_in, void* d_out, int out_size, void* d_ws, size_t ws_size, hipStream_t stream) {
  static int grid = 0;
  if (grid == 0) {
    int dev = 0, cus = 0, per_cu = 0;
    if (n_in != 21 || out_size != T * D || ws_size < WS_END) { fprintf(stderr, "kernel_launch: unexpected problem (n_in %d out %d ws %zu)\n", n_in, out_size, ws_size); grid = -1; return; }
    hipGetDevice(&dev); hipDeviceGetAttribute(&cus, hipDeviceAttributeMultiprocessorCount, dev);
    hipFuncSetAttribute((const void*)mega_fwd, hipFuncAttributeMaxDynamicSharedMemorySize, LDS_BYTES);
    if (hipOccupancyMaxActiveBlocksPerMultiprocessor(&per_cu, (const void*)mega_fwd, 512, LDS_BYTES) != hipSuccess || per_cu < 1) { fprintf(stderr, "kernel_launch: occupancy query says %d blocks per CU\n", per_cu); per_cu = 1; }
    (void)hipGetLastError();
    grid = cus;
  }
  if (grid < 0) return;
  hipMemsetAsync((char*)d_ws + WS_CTL, 0, CTL_ZERO_BYTES, stream);
  Args a{};
  for (int i = 0; i < 21; ++i) a.in[i] = (const float*)d_in[i];
  a.out = (float*)d_out; a.ws = (unsigned char*)d_ws;
  constexpr int NPH = 11;
  int ph = 0, nbar = 0;
  while (ph < NPH) {
    if ((NAIVE_MASK >> ph) & 1) { launch_naive(ph, d_in, (float*)d_out, (unsigned char*)d_ws, stream); ++ph; continue; }
    int hi = ph + 1; while (hi < NPH && !((NAIVE_MASK >> hi) & 1) && !((CUT_MASK >> (hi - 1)) & 1)) ++hi;
    a.ph_lo = ph; a.ph_hi = hi; a.bar_li = nbar; if (hi - ph > 1) ++nbar;
    a.pad = P2_RUN;
    hipLaunchKernelGGL(mega_fwd, dim3(grid), dim3(512), LDS_BYTES, stream, a);
    if (ph <= 2 && 2 < hi && P2_RUN != 3) launch_naive(P2_RUN == 1 ? 21 : 22, d_in, (float*)d_out, (unsigned char*)d_ws, stream);
    ph = hi;
  }
}
```

```cpp
#include <hip/hip_runtime.h>
#include <stdint.h>
#include <cstdio>

#ifndef NAIVE_MASK
#define NAIVE_MASK 0x0
#endif

#ifndef P2_MODE
#define P2_MODE 3
#endif
#ifndef P2_RUN
#define P2_RUN 3
#endif
#ifndef CUT_MASK
#define CUT_MASK 0x0
#endif
#define GAS __attribute__((address_space(1)))
#define LAS __attribute__((address_space(3)))
typedef unsigned short bf16_t;
typedef short bf16x8 __attribute__((ext_vector_type(8)));
typedef float f32x4 __attribute__((ext_vector_type(4)));
typedef float f32x16 __attribute__((ext_vector_type(16)));
typedef unsigned u32x4 __attribute__((ext_vector_type(4)));
typedef unsigned u32x2 __attribute__((ext_vector_type(2)));

constexpr int B = 8, S = 4096, D = 1024, T = B * S;
constexpr int GW = 64, ROWS = 64, NAH = 8, DFH = 4;
constexpr int INW = 3072, NQK = 2048, NV = 1024, E = 16, CAP = 512, FF = 1024, PLE = 256, MROWS = B * E * CAP;
constexpr float EPS = 1e-6f;
constexpr float LOG2E = 1.4426950408889634f;
constexpr float QSCALE = 0.125f * LOG2E;

constexpr size_t MiB = 1u << 20;
constexpr size_t WS_CTL = 0, CTL_ZERO_BYTES = 1 * MiB;
constexpr size_t WS_SSQ = 512 * 1024;
constexpr size_t WS_QN2 = 768 * 1024, WS_KN2 = 768 * 1024 + 8192;
constexpr size_t WS_R1 = 1 * MiB, WS_R2 = WS_R1 + 128 * 1024, WS_R3 = WS_R2 + 128 * 1024;
constexpr size_t WS_TOK = WS_R1 + 512 * 1024, WS_GSEL = WS_TOK + 256 * 1024, WS_RSEL = WS_GSEL + 256 * 1024;
constexpr size_t WS_AFF = 2 * MiB + 256 * 1024;
constexpr size_t WS_INV = 4 * MiB + 512 * 1024;
constexpr size_t WS_WQK = 8 * MiB, WS_WV = 12 * MiB, WS_WOUT = 14 * MiB, WS_WPG = 16 * MiB, WS_WPP = 18 * MiB, WS_WGU = 19 * MiB, WS_WDN = 83 * MiB;
constexpr size_t WS_XB = 116 * MiB;
constexpr size_t WS_PB = 180 * MiB;
constexpr size_t WS_QK = 196 * MiB;
constexpr size_t WS_VT = 324 * MiB;
constexpr size_t WS_END = 452 * MiB;
constexpr int CW_BAR = 1024;

constexpr int RING_BYTES = 131072, TOKL_OFF = RING_BYTES, TOKL_BYTES = 8192, MISC_OFF = TOKL_OFF + TOKL_BYTES, LDS_BYTES = 147456;

#define RLX_AGENT __ATOMIC_RELAXED, __HIP_MEMORY_SCOPE_AGENT
#define LDS_WAIT() asm volatile("s_waitcnt lgkmcnt(0)" ::: "memory")
__device__ __forceinline__ unsigned f2bf(float f) { unsigned u = __builtin_bit_cast(unsigned, f); return (u + 0x7fffu + ((u >> 16) & 1u)) >> 16; }
__device__ __forceinline__ unsigned pk2(float lo, float hi) { return f2bf(lo) | (f2bf(hi) << 16); }
__device__ __forceinline__ float bf2f(unsigned short v) { return __builtin_bit_cast(float, (unsigned)v << 16); }
__device__ __forceinline__ float bflo(unsigned w) { return __builtin_bit_cast(float, w << 16); }
__device__ __forceinline__ float bfhi(unsigned w) { return __builtin_bit_cast(float, w & 0xffff0000u); }
__device__ __forceinline__ float wave_sum(float v) {
#pragma unroll
  for (int o = 32; o > 0; o >>= 1) v += __shfl_xor(v, o);
  return v;
}
__device__ __forceinline__ float lam_value(const float* q1, const float* k1, const float* q2, const float* k2) {
  float s1 = 0.f, s2 = 0.f;
  for (int i = 0; i < 64; ++i) { s1 += q1[i] * k1[i]; s2 += q2[i] * k2[i]; }
  return expf(s1) - expf(s2) + 0.2f;
}

#define XB_TMO      128
#define XB_XCNT(j)  (256  + 64 * (j))
#define XB_XSUB(j)  (1280 + 64 * (j))
#define XB_XGEN(j)  (2304 + 64 * (j))
#define XB_TOP      3328
#define XB_TOPGEN   3392
#define XCD_BAR_WORDS 3456
#define XB_SPIN_CAP (1u << 18)
__device__ __forceinline__ unsigned xb_ld(unsigned* p)              { return __hip_atomic_load(p, __ATOMIC_RELAXED, __HIP_MEMORY_SCOPE_AGENT); }
__device__ __forceinline__ unsigned xb_add(unsigned* p, unsigned v) { return __hip_atomic_fetch_add(p, v, __ATOMIC_RELAXED, __HIP_MEMORY_SCOPE_AGENT); }
__device__ __forceinline__ unsigned xb_xcc_id() { return (unsigned)__builtin_amdgcn_s_getreg((3 << 11) | 20) & 0xFu; }
#define XB_SPIN(cond, bar) do { unsigned _sp = 0; while (cond) { __builtin_amdgcn_s_sleep(1); \
    if ((++_sp & 255u) == 0u) { if (xb_ld(&(bar)[XB_TMO])) break; if (_sp > XB_SPIN_CAP) { atomicAdd(&(bar)[XB_TMO], 1u); break; } } } } while (0)
struct XcdBarrier { unsigned* bar; unsigned x; volatile LAS unsigned* st; };
__device__ __forceinline__ XcdBarrier xcd_barrier_post(unsigned* bar, volatile LAS unsigned* st) {
  XcdBarrier b; b.bar = bar; b.x = xb_xcc_id(); b.st = st;
  if (threadIdx.x == 0) (void)xb_add(&bar[XB_XCNT(b.x)], 1u);
  return b;
}
__device__ __forceinline__ void xcd_barrier_complete(unsigned* bar, unsigned x, unsigned& nloc, unsigned& nx) {
  const unsigned G = gridDim.x * gridDim.y * gridDim.z;
  unsigned sum, cnt, mine, sp = 0u;
  for (;;) {
    sum = 0u; cnt = 0u; mine = 0u;
#pragma unroll
    for (unsigned j = 0; j < 16; ++j) { const unsigned c = xb_ld(&bar[XB_XCNT(j)]); sum += c; cnt += (c > 0u) ? 1u : 0u; mine = (j == x) ? c : mine; }
    if (sum == G) break;
    __builtin_amdgcn_s_sleep(1);
    if ((++sp & 255u) == 0u) { if (xb_ld(&bar[XB_TMO])) break; if (sp > XB_SPIN_CAP) { atomicAdd(&bar[XB_TMO], 1u); break; } }
  }
  nloc = mine > 0u ? mine : 1u; nx = cnt > 0u ? cnt : 1u;
}
__device__ __forceinline__ void xcd_barrier(const XcdBarrier& b) {
  asm volatile("s_waitcnt vmcnt(0)" ::: "memory");
  __syncthreads();
  if (threadIdx.x == 0) {
    unsigned* bar = b.bar;
    __builtin_amdgcn_s_waitcnt(0);
    unsigned nloc = b.st[0], nx = b.st[1];
    if (nloc == 0u) { xcd_barrier_complete(bar, b.x, nloc, nx); b.st[0] = nloc; b.st[1] = nx; }
    const unsigned old = xb_add(&bar[XB_XSUB(b.x)], 1u);
    const unsigned gen = old / nloc;
    if (old + 1u == (gen + 1u) * nloc) {
      __builtin_amdgcn_fence(__ATOMIC_RELEASE, "agent");
      asm volatile("s_waitcnt vmcnt(0)" ::: "memory");
      const unsigned og = xb_add(&bar[XB_TOP], 1u);
      const unsigned tg = og / nx;
      if (og + 1u == (tg + 1u) * nx) xb_add(&bar[XB_TOPGEN], 1u);
      else XB_SPIN(xb_ld(&bar[XB_TOPGEN]) == tg, bar);
      __builtin_amdgcn_fence(__ATOMIC_ACQUIRE, "agent");
      xb_add(&bar[XB_XGEN(b.x)], 1u);
      asm volatile("s_waitcnt vmcnt(0)" ::: "memory");
    } else {
      XB_SPIN(xb_ld(&bar[XB_XGEN(b.x)]) == gen, bar);
      __builtin_amdgcn_fence(__ATOMIC_ACQUIRE, "agent");
      asm volatile("s_waitcnt vmcnt(0)" ::: "memory");
    }
  }
  __syncthreads();
}

namespace pg8 {
constexpr int BM = 256, BK = 64, HALF = 128, HTB = HALF * BK * 2, STAGE_BYTES = 8 * HTB, NXCD = 8, WGM = 8;
__host__ __device__ __forceinline__ int lds_byte(int r, int c) { const int st = (r >> 4) * 2 + (c >> 5), rr = r & 15, cc = c & 31, ob = rr * 64 + cc * 2; return st * 1024 + (ob ^ (((ob >> 9) & 1) << 5)); }
__host__ __device__ __forceinline__ void stage_rc(int b, int& R, int& C) { const int st = b / 1024, sb = b % 1024, swz = sb ^ (((sb >> 9) & 1) << 5); R = (st >> 1) * 16 + swz / 64; C = (st & 1) * 32 + (swz % 64) / 2; }
__host__ __device__ __forceinline__ int perm32(int rho) { const int n = rho >> 4, i = rho & 15; return 8 * (i >> 2) + 4 * n + (i & 3); }
struct Unit { int pm, pn, z; };
struct OrderStd {
  int nM, nN, nwg, G, c; size_t tstep;
  __device__ void init(int M, int N, int K, int G_, int c_) { nM = M / BM; nN = N / BM; nwg = nM * nN; G = G_; c = c_; tstep = (size_t)BM * K * 2; }
  __device__ bool next(int i, Unit& u) const {
    const long L = (long)i * G + c; if (L >= nwg) return false;
    int wgid = (int)L; { const int q = nwg / NXCD, r = nwg % NXCD, xcd = wgid % NXCD, off = wgid / NXCD; wgid = (xcd < r ? xcd * (q + 1) : r * (q + 1) + (xcd - r) * q) + off; }
    const int nig = WGM * nN, gid = wgid / nig, fm = gid * WGM, gsz = (nM - fm) < WGM ? (nM - fm) : WGM;
    u.pm = fm + ((wgid % nig) % gsz); u.pn = (wgid % nig) / gsz; u.z = 0; return true;
  }
  __device__ size_t aoff(const Unit& u) const { return (size_t)u.pm * tstep; }
  __device__ size_t boff(const Unit& u) const { return (size_t)u.pn * tstep; }
};
struct OrderMoe {
  int G, vcu, upe, npn, total; size_t tstepA, tstepB, estepB;
  __device__ bool next(int i, Unit& u) const {
    const int L = i * G + vcu; if (L >= total) return false;
    const int e = L / upe, rem = L % upe, pnl = rem % npn, bp = rem / npn, b = bp >> 1, pml = bp & 1;
    u.z = b * E + e; u.pm = u.z * 2 + pml; u.pn = pnl; return true;
  }
  __device__ size_t aoff(const Unit& u) const { return (size_t)u.pm * tstepA; }
  __device__ size_t boff(const Unit& u) const { return (size_t)(u.z & (E - 1)) * estepB + (size_t)u.pn * tstepB; }
};
typedef float f32x2_t __attribute__((ext_vector_type(2))); typedef __bf16 bf16x2_t __attribute__((ext_vector_type(2)));
__device__ __forceinline__ unsigned cvt_pk_bf16(float lo, float hi) { f32x2_t v = {lo, hi}; bf16x2_t bb = __builtin_convertvector(v, bf16x2_t); return __builtin_bit_cast(unsigned, bb); }

template <class Epi, class Sched, bool ALIGN_EPI, bool GATHER>
__device__ __forceinline__ void gemm_phase(LAS unsigned char* lds, const char* Abase, const char* Bbase, int K, const Sched& S, const Epi& E, const LAS int* tokL) {
  const int tid = threadIdx.x, wid = __builtin_amdgcn_readfirstlane(tid >> 6), lane = tid & 63, wr = wid >> 2, wc = wid & 3, fr = lane & 15, fq = lane >> 4;
  const int nt = K / BK;
  unsigned voffA[2], voffB[2]; int RA[2], CA2[2];
#pragma unroll
  for (int i = 0; i < 2; ++i) { int R, C; stage_rc(tid * 16 + i * 8192, R, C); const int Rb = Epi::PERM ? ((R & ~31) + perm32(R & 31)) : R;
    voffA[i] = (unsigned)(R * K + C) * 2u; voffB[i] = (unsigned)(Rb * K + C) * 2u; RA[i] = R; CA2[i] = C * 2; }
  const size_t kstep = (size_t)(BK * 2);
  const size_t hstep = (size_t)HALF * K * 2;
  const unsigned ldsw = (unsigned)wid * 1024u;
  const int aoff = lds_byte(wr * 64 + fr, fq * 8), boff = lds_byte(wc * 32 + fr, fq * 8);
#define PG8_SA(b, h) (((b) * 2 + (h)) * HTB)
#define PG8_SB(b, h) ((4 + (b) * 2 + (h)) * HTB)
#define PG8_ST2(bufoff, gptr, o0, o1) do { \
    __builtin_amdgcn_global_load_lds((const unsigned*)((const char*)(gptr) + (o0)), (LAS unsigned*)(lds + (bufoff) + ldsw), 16, 0, 0); \
    __builtin_amdgcn_global_load_lds((const unsigned*)((const char*)(gptr) + (o1)), (LAS unsigned*)(lds + (bufoff) + ldsw + 8192), 16, 0, 0); } while (0)
#define PG8_STB(b, h, ptr) PG8_ST2(PG8_SB(b, h), (ptr) + (h) * hstep, voffB[0], voffB[1])
#define PG8_STA(b, h, nx, kto) do { if constexpr (GATHER) { const unsigned o0_ = (nx) ? gN[h][0] : gC[h][0], o1_ = (nx) ? gN[h][1] : gC[h][1]; PG8_ST2(PG8_SA(b, h), Abase + (kto), o0_, o1_); } \
    else { const char* ap_ = (nx) ? nA : cA; PG8_ST2(PG8_SA(b, h), ap_ + (h) * hstep + (kto), voffA[0], voffA[1]); } } while (0)
#define PG8_LDA(dst, b, h) do { _Pragma("unroll") for (int m = 0; m < 4; ++m) _Pragma("unroll") for (int k = 0; k < 2; ++k) dst[m][k] = *(const LAS bf16x8*)(lds + PG8_SA(b, h) + aoff + m * 2048 + k * 1024); } while (0)
#define PG8_LDB(dst, b, h) do { _Pragma("unroll") for (int n = 0; n < 2; ++n) _Pragma("unroll") for (int k = 0; k < 2; ++k) dst[n][k] = *(const LAS bf16x8*)(lds + PG8_SB(b, h) + boff + n * 2048 + k * 1024); } while (0)
#define PG8_MMA(ai, bj, At, Bt) do { __builtin_amdgcn_s_setprio(1); _Pragma("unroll") for (int m = 0; m < 4; ++m) _Pragma("unroll") for (int n = 0; n < 2; ++n) _Pragma("unroll") for (int k = 0; k < 2; ++k) \
        acc[ai][bj][m][n] = __builtin_amdgcn_mfma_f32_16x16x32_bf16(Bt[n][k], At[m][k], acc[ai][bj][m][n], 0, 0, 0); __builtin_amdgcn_s_setprio(0); } while (0)
#define PG8_WAIT_V(n) asm volatile("s_waitcnt vmcnt(" #n ")" ::: "memory")
#define PG8_WAIT_L(n) asm volatile("s_waitcnt lgkmcnt(" #n ")" ::: "memory")
#define PG8_BAR __builtin_amdgcn_s_barrier()
#define PG8_SCHED __builtin_amdgcn_sched_barrier(0)
  Unit cur, nxt; int ui = 0;
  if (!S.next(0, cur)) return;
  f32x4 acc[2][2][4][2];
#pragma unroll
  for (int a = 0; a < 2; ++a)
#pragma unroll
    for (int b = 0; b < 2; ++b)
#pragma unroll
      for (int m = 0; m < 4; ++m)
#pragma unroll
        for (int n = 0; n < 2; ++n) acc[a][b][m][n] = (f32x4){0.f, 0.f, 0.f, 0.f};
  bf16x8 At[4][2], B0[2][2], B1[2][2];
  unsigned gC[2][2], gN[2][2];
  const char* cA = nullptr; const char* nA = nullptr;
  if constexpr (GATHER) {
#pragma unroll
    for (int h = 0; h < 2; ++h)
#pragma unroll
      for (int i = 0; i < 2; ++i) { gC[h][i] = (unsigned)tokL[h * HALF + RA[i]] * (unsigned)(K * 2) + (unsigned)CA2[i]; gN[h][i] = gC[h][i]; }
  } else { cA = Abase + S.aoff(cur); nA = cA; gC[0][0] = gN[0][0] = 0; (void)gC; (void)gN; }
  const char* cB = Bbase + S.boff(cur);
  const char* nB = cB;
  PG8_STB(0, 0, cB); PG8_STB(0, 1, cB); PG8_STA(0, 0, false, 0); PG8_STA(0, 1, false, 0);
  if (wr == 1) PG8_BAR;
  PG8_WAIT_V(2); PG8_BAR;
  PG8_STB(1, 0, cB + kstep); PG8_STA(1, 0, false, kstep); PG8_STB(1, 1, cB + kstep);
  PG8_WAIT_V(6); PG8_BAR;
  for (;;) {
    const bool has_next = S.next(ui + 1, nxt);
    if constexpr (GATHER) {
      if (has_next) {
#pragma unroll
        for (int h = 0; h < 2; ++h)
#pragma unroll
          for (int i = 0; i < 2; ++i) gN[h][i] = (unsigned)tokL[(ui + 1) * BM + h * HALF + RA[i]] * (unsigned)(K * 2) + (unsigned)CA2[i];
      } else {
#pragma unroll
        for (int h = 0; h < 2; ++h)
#pragma unroll
          for (int i = 0; i < 2; ++i) gN[h][i] = gC[h][i];
      }
    } else { nA = has_next ? Abase + S.aoff(nxt) : cA; }
    nB = has_next ? Bbase + S.boff(nxt) : cB;
    for (int t = 0; t < nt; t += 2) {
      const bool last = (t == nt - 2);
      const size_t k1 = (size_t)(t + 1) * kstep;
      const size_t k2 = last ? 0 : (size_t)(t + 2) * kstep, k3 = k2 + kstep;
      const char* b2 = (last ? nB : cB) + k2; const char* b3 = b2 + kstep;
      PG8_LDB(B0, 0, 0); PG8_LDB(B1, 0, 1); PG8_SCHED; PG8_LDA(At, 0, 0); PG8_STA(1, 1, false, k1);
      PG8_WAIT_V(8); PG8_WAIT_L(0); PG8_BAR; PG8_MMA(0, 0, At, B0); PG8_MMA(0, 1, At, B1); PG8_BAR; PG8_SCHED;
      PG8_LDA(At, 0, 1); PG8_STB(0, 0, b2); PG8_STB(0, 1, b2); PG8_STA(0, 0, last, k2);
      PG8_WAIT_V(8); PG8_WAIT_L(0); PG8_BAR; PG8_MMA(1, 0, At, B0); PG8_MMA(1, 1, At, B1); PG8_BAR; PG8_SCHED;
      PG8_LDB(B0, 1, 0); PG8_LDB(B1, 1, 1); PG8_SCHED; PG8_LDA(At, 1, 0); PG8_STA(0, 1, last, k2);
      PG8_WAIT_V(8); PG8_WAIT_L(0); PG8_BAR; PG8_MMA(0, 0, At, B0); PG8_MMA(0, 1, At, B1); PG8_BAR; PG8_SCHED;
      PG8_LDA(At, 1, 1); PG8_STB(1, 0, b3); PG8_STB(1, 1, b3); PG8_STA(1, 0, last, k3);
      PG8_WAIT_V(8); PG8_WAIT_L(0); PG8_BAR; PG8_MMA(1, 0, At, B0); PG8_MMA(1, 1, At, B1); PG8_BAR; PG8_SCHED;
    }
    if constexpr (ALIGN_EPI) { if (wr == 0) PG8_BAR; }
    E(acc, cur, wr, wc, fr, fq);
    if (!has_next) break;
#pragma unroll
    for (int a = 0; a < 2; ++a)
#pragma unroll
      for (int b = 0; b < 2; ++b)
#pragma unroll
        for (int m = 0; m < 4; ++m)
#pragma unroll
          for (int n = 0; n < 2; ++n) acc[a][b][m][n] = (f32x4){0.f, 0.f, 0.f, 0.f};
    cur = nxt; cA = nA; cB = nB; ++ui;
    if constexpr (GATHER) {
#pragma unroll
      for (int h = 0; h < 2; ++h)
#pragma unroll
        for (int i = 0; i < 2; ++i) gC[h][i] = gN[h][i];
    }
    if constexpr (ALIGN_EPI) { if (wr == 1) PG8_BAR; }
  }
  PG8_WAIT_V(0);
  if constexpr (!ALIGN_EPI) { if (wr == 0) PG8_BAR; }
  PG8_BAR;
#undef PG8_SA
#undef PG8_SB
#undef PG8_ST2
#undef PG8_STB
#undef PG8_STA
#undef PG8_LDA
#undef PG8_LDB
#undef PG8_MMA
#undef PG8_WAIT_V
#undef PG8_WAIT_L
#undef PG8_BAR
#undef PG8_SCHED
}

typedef const f32x4 (&AccT)[2][2][4][2];
struct EpiQK {
  static constexpr bool PERM = true;
  bf16_t* O; const float* rs;
  __device__ __forceinline__ void operator()(AccT acc, const Unit& u, int wr, int wc, int fr, int fq) const {
    const int row0 = u.pm * BM + wr * 64 + fr, col0 = u.pn * BM + wc * 32 + 8 * fq;
#pragma unroll
    for (int ai = 0; ai < 2; ++ai)
#pragma unroll
      for (int m = 0; m < 4; ++m) { const int row = row0 + ai * HALF + m * 16; const float s = rs[row]; bf16_t* rowp = O + (size_t)row * NQK + col0;
#pragma unroll
        for (int bj = 0; bj < 2; ++bj) { const f32x4 v0 = acc[ai][bj][m][0] * s, v1 = acc[ai][bj][m][1] * s;
          u32x4 w; w.x = cvt_pk_bf16(v0[0], v0[1]); w.y = cvt_pk_bf16(v0[2], v0[3]); w.z = cvt_pk_bf16(v1[0], v1[1]); w.w = cvt_pk_bf16(v1[2], v1[3]);
          *(u32x4*)(rowp + bj * HALF) = w; } }
  }
};
struct EpiVT {
  static constexpr bool PERM = true;
  bf16_t* O; const float* rs;
  __device__ __forceinline__ void operator()(AccT acc, const Unit& u, int wr, int wc, int fr, int fq) const {
    const int row0 = u.pm * BM + wr * 64 + fr, tok0 = u.pn * BM + wc * 32 + 8 * fq;
    const int bb = u.pn >> 4, s0 = (u.pn & 15) * BM + wc * 32 + 8 * fq;
    f32x4 cs[2][2];
#pragma unroll
    for (int bj = 0; bj < 2; ++bj)
#pragma unroll
      for (int n = 0; n < 2; ++n) cs[bj][n] = *(const f32x4*)(rs + tok0 + bj * HALF + 4 * n);
#pragma unroll
    for (int ai = 0; ai < 2; ++ai)
#pragma unroll
      for (int m = 0; m < 4; ++m) { const int row = row0 + ai * HALF + m * 16; bf16_t* rowp = O + ((size_t)(bb * NV + row)) * S + s0;
#pragma unroll
        for (int bj = 0; bj < 2; ++bj) { const f32x4 v0 = acc[ai][bj][m][0] * cs[bj][0], v1 = acc[ai][bj][m][1] * cs[bj][1];
          u32x4 w; w.x = cvt_pk_bf16(v0[0], v0[1]); w.y = cvt_pk_bf16(v0[2], v0[3]); w.z = cvt_pk_bf16(v1[0], v1[1]); w.w = cvt_pk_bf16(v1[2], v1[3]);
          *(u32x4*)(rowp + bj * HALF) = w; } }
  }
};
struct EpiH {
  static constexpr bool PERM = false;
  bf16_t* Hb; const float* X;
  __device__ __forceinline__ void operator()(AccT acc, const Unit& u, int wr, int wc, int fr, int fq) const {
    const int row0 = u.pm * BM + wr * 64 + fr, col0 = u.pn * BM + wc * 32 + 4 * fq;
#pragma unroll
    for (int ai = 0; ai < 2; ++ai)
#pragma unroll
      for (int m = 0; m < 4; ++m) { const size_t off = (size_t)(row0 + ai * HALF + m * 16) * D + col0;
#pragma unroll
        for (int bj = 0; bj < 2; ++bj)
#pragma unroll
          for (int n = 0; n < 2; ++n) { const size_t o = off + bj * HALF + n * 16; const f32x4 hv = *(const f32x4*)(X + o) + acc[ai][bj][m][n];
            u32x2 w; w.x = cvt_pk_bf16(hv[0], hv[1]); w.y = cvt_pk_bf16(hv[2], hv[3]); *(u32x2*)(Hb + o) = w; } }
  }
};
__device__ __forceinline__ float silu_mul(float g, float u) { return g * __builtin_amdgcn_rcpf(1.0f + __builtin_amdgcn_exp2f(-g * LOG2E)) * u; }
struct EpiMoe1 {
  static constexpr bool PERM = true;
  bf16_t* Hid; const float* rsel;
  __device__ __forceinline__ void operator()(AccT acc, const Unit& u, int wr, int wc, int fr, int fq) const {
    const int row0 = u.pm * BM + wr * 64 + fr, col0 = u.pn * HALF + wc * 32 + 8 * fq;
#pragma unroll
    for (int ai = 0; ai < 2; ++ai)
#pragma unroll
      for (int m = 0; m < 4; ++m) { const int row = row0 + ai * HALF + m * 16; const float s = rsel[row];
        const f32x4 g0 = acc[ai][0][m][0] * s, g1 = acc[ai][0][m][1] * s, u0 = acc[ai][1][m][0] * s, u1 = acc[ai][1][m][1] * s;
        u32x4 w; w.x = cvt_pk_bf16(silu_mul(g0[0], u0[0]), silu_mul(g0[1], u0[1])); w.y = cvt_pk_bf16(silu_mul(g0[2], u0[2]), silu_mul(g0[3], u0[3]));
        w.z = cvt_pk_bf16(silu_mul(g1[0], u1[0]), silu_mul(g1[1], u1[1])); w.w = cvt_pk_bf16(silu_mul(g1[2], u1[2]), silu_mul(g1[3], u1[3]));
        *(u32x4*)(Hid + (size_t)row * FF + col0) = w; }
  }
};
struct EpiRowScale {
  static constexpr bool PERM = true;
  bf16_t* O; const float* rs;
  __device__ __forceinline__ void operator()(AccT acc, const Unit& u, int wr, int wc, int fr, int fq) const {
    const int row0 = u.pm * BM + wr * 64 + fr, col0 = u.pn * BM + wc * 32 + 8 * fq;
#pragma unroll
    for (int ai = 0; ai < 2; ++ai)
#pragma unroll
      for (int m = 0; m < 4; ++m) { const int row = row0 + ai * HALF + m * 16; const float s = rs ? rs[row] : 1.0f; bf16_t* rowp = O + (size_t)row * D + col0;
#pragma unroll
        for (int bj = 0; bj < 2; ++bj) { const f32x4 v0 = acc[ai][bj][m][0] * s, v1 = acc[ai][bj][m][1] * s;
          u32x4 w; w.x = cvt_pk_bf16(v0[0], v0[1]); w.y = cvt_pk_bf16(v0[2], v0[3]); w.z = cvt_pk_bf16(v1[0], v1[1]); w.w = cvt_pk_bf16(v1[2], v1[3]);
          *(u32x4*)(rowp + bj * HALF) = w; } }
  }
};
struct EpiPle {
  static constexpr bool PERM = false;
  float* H; const bf16_t* H2; const bf16_t* PP; const float* r3; float* ssq;
  __device__ __forceinline__ void operator()(AccT acc, const Unit& u, int wr, int wc, int fr, int fq) const {
    const int row0 = u.pm * BM + wr * 64 + fr, col0 = u.pn * BM + wc * 32 + 4 * fq;
#pragma unroll
    for (int ai = 0; ai < 2; ++ai)
#pragma unroll
      for (int m = 0; m < 4; ++m) { const int row = row0 + ai * HALF + m * 16; const size_t off = (size_t)row * D + col0; const float rr = r3[row] * LOG2E; float ss = 0.f;
#pragma unroll
        for (int bj = 0; bj < 2; ++bj)
#pragma unroll
          for (int n = 0; n < 2; ++n) { const size_t o = off + bj * HALF + n * 16; const f32x4 a = acc[ai][bj][m][n]; const u32x2 hw = *(const u32x2*)(H2 + o); const u32x2 pw = *(const u32x2*)(PP + o);
            f32x4 r; r[0] = bflo(hw.x) + __builtin_amdgcn_rcpf(1.0f + __builtin_amdgcn_exp2f(-a[0] * rr)) * bflo(pw.x); r[1] = bfhi(hw.x) + __builtin_amdgcn_rcpf(1.0f + __builtin_amdgcn_exp2f(-a[1] * rr)) * bfhi(pw.x);
            r[2] = bflo(hw.y) + __builtin_amdgcn_rcpf(1.0f + __builtin_amdgcn_exp2f(-a[2] * rr)) * bflo(pw.y); r[3] = bfhi(hw.y) + __builtin_amdgcn_rcpf(1.0f + __builtin_amdgcn_exp2f(-a[3] * rr)) * bfhi(pw.y);
            *(f32x4*)(H + o) = r; ss += (r[0] * r[0] + r[1] * r[1]) + (r[2] * r[2] + r[3] * r[3]); }
        ss += __shfl_xor(ss, 16); ss += __shfl_xor(ss, 32);
        if (fq == 0) atomicAdd(ssq + row, ss); }
  }
};
}

struct Args { const float* in[21]; float* out; unsigned char* ws; int ph_lo, ph_hi, bar_li, pad; };
struct Frame {
  LAS unsigned char* lds; int tid, lane, wave, vcu, G;
  const float *x, *p, *g_mix, *w_in, *rpb, *g_na, *lq1, *lk1, *lq2, *lk2, *g_df, *w_out, *g_moe, *w_router, *w_gate, *w_up, *w_down, *g_ple, *w_pg, *w_pp, *g_final;
  float* out; unsigned char* ws;
};
#define WSP(T_, off) ((T_*)(F.ws + (off)))

__device__ __forceinline__ void tr_item(const float* W, int ldw, int k0, int sc0, bf16_t* WT, size_t drow0, int Kd, int gmode, const float* g0, const float* g1, float cscale, LAS float* scr, int lane) {
#pragma unroll 8
  for (int i = 0; i < 32; ++i) { const int kk = 2 * i + (lane >> 5), k = k0 + kk;
    float gv = cscale;
    if (gmode == 1) gv *= g0[k]; else if (gmode == 2) gv *= (k < 512) ? g0[k] : 0.8f * g1[(k - 512) & 127];
    scr[kk * 33 + (lane & 31)] = W[(size_t)k * ldw + sc0 + (lane & 31)] * gv; }
  LDS_WAIT(); asm volatile("" ::: "memory");
  const int c = lane & 7;
#pragma unroll
  for (int j = 0; j < 4; ++j) { const int n = (lane >> 3) + 8 * j; const LAS float* s = scr + (8 * c) * 33 + n;
    u32x4 o; o.x = pk2(s[0 * 33], s[1 * 33]); o.y = pk2(s[2 * 33], s[3 * 33]); o.z = pk2(s[4 * 33], s[5 * 33]); o.w = pk2(s[6 * 33], s[7 * 33]);
    *(u32x4*)(WT + (drow0 + n) * Kd + k0 + 8 * c) = o; }
  LDS_WAIT(); asm volatile("" ::: "memory");
}
__device__ __forceinline__ void p0_prologue(Frame& F) {
  LAS float* scr = (LAS float*)(F.lds + F.wave * 16384);
  const int gw = F.vcu * 8 + F.wave, NGW = F.G * 8;
  constexpr int I_A = 512, I_B = 512, I_C = 256, I_D = 256, I_O = 512, I_PG = 512, I_PP = 128, I_EX = 8192;
  constexpr int NITEMS = I_A + I_B + I_C + I_D + I_O + I_PG + I_PP + 3 * I_EX;
  for (int it = gw; it < NITEMS; it += NGW) {
    int r = it;
    if (r < I_A) { const int kb = r / 32, nb = r % 32; tr_item(F.w_in, INW, kb * 64, nb * 32, WSP(bf16_t, WS_WQK), nb * 32, D, 1, F.g_mix, nullptr, nb < 16 ? QSCALE : 1.0f, scr, F.lane); continue; } r -= I_A;
    if (r < I_B) { const int kb = r / 32, nb = r % 32; tr_item(F.w_in, INW, kb * 64, 1536 + nb * 32, WSP(bf16_t, WS_WQK), 1024 + nb * 32, D, 1, F.g_mix, nullptr, nb < 16 ? QSCALE : 1.0f, scr, F.lane); continue; } r -= I_B;
    if (r < I_C) { const int kb = r / 16, nb = r % 16; tr_item(F.w_in, INW, kb * 64, 1024 + nb * 32, WSP(bf16_t, WS_WV), nb * 32, D, 1, F.g_mix, nullptr, 1.0f, scr, F.lane); continue; } r -= I_C;
    if (r < I_D) { const int kb = r / 16, nb = r % 16; tr_item(F.w_in, INW, kb * 64, 2560 + nb * 32, WSP(bf16_t, WS_WV), 512 + nb * 32, D, 1, F.g_mix, nullptr, 1.0f, scr, F.lane); continue; } r -= I_D;
    if (r < I_O) { const int kb = r / 32, nb = r % 32; tr_item(F.w_out, D, kb * 64, nb * 32, WSP(bf16_t, WS_WOUT), nb * 32, D, 2, F.g_na, F.g_df, 1.0f, scr, F.lane); continue; } r -= I_O;
    if (r < I_PG) { const int kb = r / 32, nb = r % 32; tr_item(F.w_pg, D, kb * 64, nb * 32, WSP(bf16_t, WS_WPG), nb * 32, D, 1, F.g_ple, nullptr, 1.0f, scr, F.lane); continue; } r -= I_PG;
    if (r < I_PP) { const int kb = r / 32, nb = r % 32; tr_item(F.w_pp, D, kb * 64, nb * 32, WSP(bf16_t, WS_WPP), nb * 32, PLE, 0, nullptr, nullptr, 1.0f, scr, F.lane); continue; } r -= I_PP;
    if (r < 2 * I_EX) { const int up = r / I_EX; r %= I_EX; const int e = r / 512, q = r % 512, kb = q / 32, nb = q % 32, f0 = nb * 32;
      tr_item((up ? F.w_up : F.w_gate) + (size_t)e * D * FF, FF, kb * 64, f0, WSP(bf16_t, WS_WGU), (size_t)e * 2048 + (f0 >> 7) * 256 + up * 128 + (f0 & 127), D, 1, F.g_moe, nullptr, 1.0f, scr, F.lane); continue; } r -= 2 * I_EX;
    { const int e = r / 512, q = r % 512, kb = q / 32, nb = q % 32;
      tr_item(F.w_down + (size_t)e * FF * D, D, kb * 64, nb * 32, WSP(bf16_t, WS_WDN), (size_t)e * 1024 + nb * 32, FF, 0, nullptr, nullptr, 1.0f, scr, F.lane); }
  }
  float* r1 = WSP(float, WS_R1); bf16_t* xb = WSP(bf16_t, WS_XB);
  for (int m = gw; m < T; m += NGW) {
    const f32x4* xr = (const f32x4*)(F.x + (size_t)m * D) + F.lane; f32x4 v[4]; float s = 0.f;
#pragma unroll
    for (int j = 0; j < 4; ++j) { v[j] = xr[64 * j]; s += (v[j].x * v[j].x + v[j].y * v[j].y) + (v[j].z * v[j].z + v[j].w * v[j].w); }
    s = wave_sum(s);
    if (F.lane == 0) r1[m] = rsqrtf(s * (1.0f / D) + EPS);
    u32x2* o8 = (u32x2*)(xb + (size_t)m * D) + F.lane;
#pragma unroll
    for (int j = 0; j < 4; ++j) { u32x2 w; w.x = pk2(v[j].x, v[j].y); w.y = pk2(v[j].z, v[j].w); o8[64 * j] = w; }
  }
  { const f32x4* ps = (const f32x4*)F.p; u32x2* pd = WSP(u32x2, WS_PB); const int n4 = T * PLE / 4;
    for (int i = F.vcu * 512 + F.tid; i < n4; i += F.G * 512) { const f32x4 v = ps[i]; u32x2 w; w.x = pk2(v.x, v.y); w.y = pk2(v.z, v.w); pd[i] = w; } }
}

constexpr int ABUF = 32768;
constexpr int RPB_OFF = 2 * ABUF;
template <int MODE>
__device__ __forceinline__ void attn_unit(Frame& F, int b, int h, int qblk, float lam) {
  constexpr int NC = MODE ? 1 : 2, DV = MODE ? 64 : 128, NDB = DV / 32, QPU = MODE ? 256 : 128;
  const int tid = F.tid, lane = F.lane, wid = F.wave, q = lane & 31, hh = lane >> 5;
  const int cw = MODE ? 0 : (wid & 1), qg = MODE ? wid : (wid >> 1);
  const bf16_t* QK = WSP(const bf16_t, WS_QK); const bf16_t* VT = WSP(const bf16_t, WS_VT); bf16_t* ON = WSP(bf16_t, WS_XB);
  const int qcol = MODE ? h * 64 : 1024 + h * 128, kcol = MODE ? 512 + h * 64 : 1536 + h * 128, vrow0 = MODE ? h * 64 : 512 + h * 128;
  const size_t tb = (size_t)b * S;
  const int s_q = qblk * QPU + qg * 32 + q;
  const int gr = qblk * 4 + (wid >> 1), qc = (wid & 1) * 32 + q;
  const int rs_w = min(max(gr - 4, 0), ROWS - 8);
  const int cs_q = min(max(qc - 8, 0), GW - 16);
  int kr0, NT;
  if (MODE) { const int r0 = qblk * 4; kr0 = min(max(r0 - 4, 0), ROWS - 8); const int r3 = r0 + 3; NT = min(max(r3 - 4, 0), ROWS - 8) + 8 - kr0; }
  else { kr0 = 0; NT = S / 64; }
  LAS float* rpbL = (LAS float*)(F.lds + RPB_OFF);
  __syncthreads();
  if (MODE) { if (tid < 480) { const int dr = tid >> 5, dc = tid & 31; rpbL[tid] = (dc < 31) ? F.rpb[(h * 15 + dr) * 31 + dc] * LOG2E : 0.f; } }
  const int srow = wid * 8 + (lane >> 3), sslot = lane & 7;
  const bf16_t* kg = QK + (tb + (size_t)kr0 * 64 + srow) * NQK + kcol + ((sslot ^ ((srow >> 1) & 7)) * 8);
  const bf16_t* vg = VT + ((size_t)b * NV + vrow0 + srow) * S + (size_t)kr0 * 64 + ((sslot ^ ((srow >> 1) & 7)) * 8);
#define ATT_STAGE(t, buf) do { LAS unsigned char* bp_ = F.lds + (buf) * ABUF + wid * 1024; \
    _Pragma("unroll") for (int c = 0; c < NC; ++c) __builtin_amdgcn_global_load_lds((const unsigned*)(kg + (size_t)(t) * 64 * NQK + c * 64), (LAS unsigned*)(bp_ + c * 8192), 16, 0, 0); \
    _Pragma("unroll") for (int j = 0; j < DV / 64; ++j) __builtin_amdgcn_global_load_lds((const unsigned*)(vg + (size_t)j * 64 * S + (size_t)(t) * 64), (LAS unsigned*)(bp_ + 16384 + j * 8192), 16, 0, 0); } while (0)
  ATT_STAGE(0, 0);
  bf16x8 Qf[4];
  { const bf16_t* qp = QK + (tb + s_q) * NQK + qcol + cw * 64 + hh * 8;
#pragma unroll
    for (int st = 0; st < 4; ++st) Qf[st] = *(const bf16x8*)(qp + st * 16); }
  f32x16 O[NDB]; float mrun = -INFINITY, lrun = 0.f;
#pragma unroll
  for (int db = 0; db < NDB; ++db)
#pragma unroll
    for (int r = 0; r < 16; ++r) O[db][r] = 0.f;
  const int prow = (q & 0x13) | ((q & 4) << 1) | ((q & 8) >> 1);
  int kad[4], vad[4];
#pragma unroll
  for (int i = 0; i < 4; ++i) { kad[i] = cw * 8192 + prow * 128 + (((2 * i + hh) ^ ((prow >> 1) & 7)) << 4); vad[i] = 16384 + q * 128 + (((2 * i + hh) ^ ((q >> 1) & 7)) << 4); }
  const float sl2 = MODE ? 0.f : exp2f(-2.0f * (float)(h + 1)) * LOG2E;
  const float fq_pos = (float)s_q;
  asm volatile("s_waitcnt vmcnt(0)" ::: "memory");
  __syncthreads();
  for (int t = 0; t < NT; ++t) {
    if (t + 1 < NT) ATT_STAGE(t + 1, (t + 1) & 1);
    const LAS unsigned char* bp = F.lds + (t & 1) * ABUF;
    const int krow = kr0 + t;
    const bool active = MODE ? (krow >= rs_w && krow < rs_w + 8) : true;
    if (active) {
      f32x16 s0, s1;
#pragma unroll
      for (int r = 0; r < 16; ++r) { s0[r] = 0.f; s1[r] = 0.f; }
#pragma unroll
      for (int st = 0; st < 4; ++st) {
        const bf16x8 k0 = *(const LAS bf16x8*)(bp + kad[st]), k1 = *(const LAS bf16x8*)(bp + 4096 + kad[st]);
        s0 = __builtin_amdgcn_mfma_f32_32x32x16_bf16(k0, Qf[st], s0, 0, 0, 0);
        s1 = __builtin_amdgcn_mfma_f32_32x32x16_bf16(k1, Qf[st], s1, 0, 0, 0);
      }
      if (MODE) {
        const LAS float* rp = rpbL + (krow - gr + 7) * 32 - qc + 15;
#pragma unroll
        for (int r = 0; r < 16; ++r) { const int kc0 = 16 * (r >> 3) + 8 * hh + (r & 7), kc1 = kc0 + 32;
          s0[r] = (kc0 >= cs_q && kc0 < cs_q + 16) ? s0[r] + rp[kc0] : -INFINITY;
          s1[r] = (kc1 >= cs_q && kc1 < cs_q + 16) ? s1[r] + rp[kc1] : -INFINITY; }
      } else {
        const float d0 = fq_pos - (float)(t * 64 + 8 * hh);
#pragma unroll
        for (int r = 0; r < 16; ++r) { const float dd = d0 - (float)(16 * (r >> 3) + (r & 7));
          s0[r] = __builtin_fmaf(-sl2, __builtin_fabsf(dd), s0[r]); s1[r] = __builtin_fmaf(-sl2, __builtin_fabsf(dd - 32.0f), s1[r]); }
      }
      float mx = s0[0];
#pragma unroll
      for (int r = 1; r < 16; ++r) mx = fmaxf(mx, s0[r]);
#pragma unroll
      for (int r = 0; r < 16; ++r) mx = fmaxf(mx, s1[r]);
      mx = fmaxf(mx, __shfl_xor(mx, 32));
      const float mnew = fmaxf(mrun, mx);
      const float alpha = __builtin_amdgcn_exp2f(mrun - mnew);
      mrun = mnew;
      if (__any(alpha != 1.0f)) {
        lrun *= alpha;
#pragma unroll
        for (int db = 0; db < NDB; ++db)
#pragma unroll
          for (int r = 0; r < 16; ++r) O[db][r] *= alpha;
      }
      float ls = 0.f;
#pragma unroll
      for (int r = 0; r < 16; ++r) { s0[r] = __builtin_amdgcn_exp2f(s0[r] - mnew); s1[r] = __builtin_amdgcn_exp2f(s1[r] - mnew); ls += s0[r] + s1[r]; }
      lrun += ls;
#pragma unroll
      for (int kb = 0; kb < 2; ++kb)
#pragma unroll
        for (int sx = 0; sx < 2; ++sx) {
          u32x4 pw;
          if (kb == 0) { pw.x = pg8::cvt_pk_bf16(s0[8 * sx + 0], s0[8 * sx + 1]); pw.y = pg8::cvt_pk_bf16(s0[8 * sx + 2], s0[8 * sx + 3]); pw.z = pg8::cvt_pk_bf16(s0[8 * sx + 4], s0[8 * sx + 5]); pw.w = pg8::cvt_pk_bf16(s0[8 * sx + 6], s0[8 * sx + 7]); }
          else { pw.x = pg8::cvt_pk_bf16(s1[8 * sx + 0], s1[8 * sx + 1]); pw.y = pg8::cvt_pk_bf16(s1[8 * sx + 2], s1[8 * sx + 3]); pw.z = pg8::cvt_pk_bf16(s1[8 * sx + 4], s1[8 * sx + 5]); pw.w = pg8::cvt_pk_bf16(s1[8 * sx + 6], s1[8 * sx + 7]); }
          const bf16x8 pf = __builtin_bit_cast(bf16x8, pw);
#pragma unroll
          for (int db = 0; db < NDB; ++db) {
            const bf16x8 vf = *(const LAS bf16x8*)(bp + db * 4096 + vad[kb * 2 + sx]);
            O[db] = __builtin_amdgcn_mfma_f32_32x32x16_bf16(vf, pf, O[db], 0, 0, 0);
          }
        }
    }
    asm volatile("s_waitcnt vmcnt(0)" ::: "memory");
    __syncthreads();
  }
#undef ATT_STAGE
  float lt = lrun; lt += __shfl_xor(lt, 32);
  const float inv = 1.0f / lt;
  if (!MODE) {
    LAS float* xch = (LAS float*)F.lds + (size_t)qg * 64 * 64 + lane;
    if (cw == 1) {
      const float sc = inv * lam;
#pragma unroll
      for (int db = 0; db < NDB; ++db)
#pragma unroll
        for (int r = 0; r < 16; ++r) xch[(db * 16 + r) * 64] = O[db][r] * sc;
    }
    __syncthreads();
    if (cw == 1) return;
#pragma unroll
    for (int db = 0; db < NDB; ++db)
#pragma unroll
      for (int r = 0; r < 16; ++r) O[db][r] = O[db][r] * inv - xch[(db * 16 + r) * 64];
  } else {
#pragma unroll
    for (int db = 0; db < NDB; ++db)
#pragma unroll
      for (int r = 0; r < 16; ++r) O[db][r] *= inv;
  }
  float ss = 0.f;
#pragma unroll
  for (int db = 0; db < NDB; ++db)
#pragma unroll
    for (int r = 0; r < 16; ++r) ss += O[db][r] * O[db][r];
  ss += __shfl_xor(ss, 32);
  const float rn = rsqrtf(ss * (1.0f / DV) + EPS);
  bf16_t* op = ON + (tb + s_q) * D + (MODE ? h * 64 : 512 + h * 128) + 4 * hh;
#pragma unroll
  for (int db = 0; db < NDB; ++db)
#pragma unroll
    for (int g4 = 0; g4 < 4; ++g4) { u32x2 w; w.x = pg8::cvt_pk_bf16(O[db][4 * g4 + 0] * rn, O[db][4 * g4 + 1] * rn); w.y = pg8::cvt_pk_bf16(O[db][4 * g4 + 2] * rn, O[db][4 * g4 + 3] * rn);
      *(u32x2*)(op + db * 32 + g4 * 8) = w; }
}
__device__ __forceinline__ void p2n_norms(Frame& F) {
  const bf16_t* QK = WSP(const bf16_t, WS_QK); unsigned* qn2 = WSP(unsigned, WS_QN2); unsigned* kn2 = WSP(unsigned, WS_KN2);
  const int gw = F.vcu * 8 + F.wave, NGW = F.G * 8, lane = F.lane;
  for (int blk = gw; blk < T / 16; blk += NGW) {
    float mq = 0.f, mk = 0.f;
    const bf16_t* base = QK + (size_t)blk * 16 * NQK + 1024 + 8 * lane;
#pragma unroll 4
    for (int r = 0; r < 16; ++r) {
      const u32x4 a = *(const u32x4*)(base + (size_t)r * NQK), c = *(const u32x4*)(base + (size_t)r * NQK + 512);
      float sq = bflo(a.x) * bflo(a.x) + bfhi(a.x) * bfhi(a.x) + bflo(a.y) * bflo(a.y) + bfhi(a.y) * bfhi(a.y) + bflo(a.z) * bflo(a.z) + bfhi(a.z) * bfhi(a.z) + bflo(a.w) * bflo(a.w) + bfhi(a.w) * bfhi(a.w);
      float sk = bflo(c.x) * bflo(c.x) + bfhi(c.x) * bfhi(c.x) + bflo(c.y) * bflo(c.y) + bfhi(c.y) * bfhi(c.y) + bflo(c.z) * bflo(c.z) + bfhi(c.z) * bfhi(c.z) + bflo(c.w) * bflo(c.w) + bfhi(c.w) * bfhi(c.w);
      sq += __shfl_xor(sq, 1); sq += __shfl_xor(sq, 2); sq += __shfl_xor(sq, 4);
      sk += __shfl_xor(sk, 1); sk += __shfl_xor(sk, 2); sk += __shfl_xor(sk, 4);
      mq = fmaxf(mq, sq); mk = fmaxf(mk, sk);
    }
    if ((lane & 7) == 0) {
      const int hc = lane >> 3, t0 = blk * 16, b = t0 / S, qblk = (t0 % S) >> 7;
      atomicMax(qn2 + ((b * 8 + hc) * 32 + qblk), __builtin_bit_cast(unsigned, mq * 1.002f));
      atomicMax(kn2 + (b * 8 + hc), __builtin_bit_cast(unsigned, mk * 1.002f));
    }
  }
}

constexpr int DSLOT = 32768;
constexpr float DTHR = 10.0f;
__device__ __forceinline__ void diff_unit(Frame& F, int b, int h, int qblk, float lam, int jlo, int jhi) {
  const int lane = F.lane, wid = F.wave, q = lane & 31, hh = lane >> 5, cw = wid & 1, qg = wid >> 1;
  const bf16_t* QK = WSP(const bf16_t, WS_QK); const bf16_t* VT = WSP(const bf16_t, WS_VT); bf16_t* ON = WSP(bf16_t, WS_XB);
  const int qcol = 1024 + h * 128, kcol = 1536 + h * 128, vrow0 = 512 + h * 128;
  const size_t tb = (size_t)b * S;
  const int s_q = qblk * 128 + qg * 32 + q;
  const int jd0 = qblk * 2, jw = jd0 + (qg >> 1);
  const int NT = jhi - jlo + 1, nright = jhi - jd0;
#define DJ(t) (((t) <= nright) ? (jd0 + (t)) : (jd0 - ((t) - nright)))
  __syncthreads();
  const int srow = wid * 8 + (lane >> 3), sslot = lane & 7;
  const bf16_t* kg = QK + (tb + srow) * NQK + kcol + ((sslot ^ ((srow >> 1) & 7)) * 8);
  const bf16_t* vg = VT + ((size_t)b * NV + vrow0 + srow) * S + ((sslot ^ ((srow >> 1) & 7)) * 8);
#define DDMA(tt) do { const int tt_ = (tt); LAS unsigned char* bp_ = F.lds + (tt_ & 3) * DSLOT + wid * 1024; const size_t J_ = (size_t)DJ(tt_); \
    __builtin_amdgcn_global_load_lds((const unsigned*)(kg + J_ * 64 * NQK), (LAS unsigned*)(bp_), 16, 0, 0); \
    __builtin_amdgcn_global_load_lds((const unsigned*)(kg + J_ * 64 * NQK + 64), (LAS unsigned*)(bp_ + 8192), 16, 0, 0); \
    __builtin_amdgcn_global_load_lds((const unsigned*)(vg + J_ * 64), (LAS unsigned*)(bp_ + 16384), 16, 0, 0); \
    __builtin_amdgcn_global_load_lds((const unsigned*)(vg + (size_t)64 * S + J_ * 64), (LAS unsigned*)(bp_ + 24576), 16, 0, 0); } while (0)
  DDMA(0); DDMA(1);
  if (NT > 2) DDMA(2);
  bf16x8 Qf[4];
  { const bf16_t* qp = QK + (tb + s_q) * NQK + qcol + cw * 64 + hh * 8;
#pragma unroll
    for (int st = 0; st < 4; ++st) Qf[st] = *(const bf16x8*)(qp + st * 16); }
  f32x16 O[4]; float mref = 0.f, lrun = 0.f;
#pragma unroll
  for (int db = 0; db < 4; ++db)
#pragma unroll
    for (int r = 0; r < 16; ++r) O[db][r] = 0.f;
  const int prow = (q & 0x13) | ((q & 4) << 1) | ((q & 8) >> 1);
  int kad[4], vad[4];
#pragma unroll
  for (int i = 0; i < 4; ++i) { kad[i] = cw * 8192 + prow * 128 + (((2 * i + hh) ^ ((prow >> 1) & 7)) << 4); vad[i] = 16384 + q * 128 + (((2 * i + hh) ^ ((q >> 1) & 7)) << 4); }
  const float sl2 = exp2f(-2.0f * (float)(h + 1)) * LOG2E;
  asm volatile("s_waitcnt vmcnt(0)" ::: "memory");
  __syncthreads();
  bf16x8 kf[4][2], va[4], vb[4]; u32x4 pw[4];
#define DKLOAD(tt) do { const LAS unsigned char* kb_ = F.lds + ((tt) & 3) * DSLOT; _Pragma("unroll") for (int st = 0; st < 4; ++st) { kf[st][0] = *(const LAS bf16x8*)(kb_ + kad[st]); kf[st][1] = *(const LAS bf16x8*)(kb_ + 4096 + kad[st]); } } while (0)
#define D_SM(t) do { const int J = DJ(t); const LAS unsigned char* bp = F.lds + ((t) & 3) * DSLOT; \
    f32x16 s0, s1; const float dl = (float)(s_q - 64 * J - 8 * hh); \
    if (J == jw) { _Pragma("unroll") for (int r = 0; r < 16; ++r) { const float off = (float)(16 * (r >> 3) + (r & 7)); \
        s0[r] = __builtin_fmaf(-sl2, __builtin_fabsf(dl - off), -mref); s1[r] = __builtin_fmaf(-sl2, __builtin_fabsf(dl - off - 32.0f), -mref); } } \
    else { const float sgl = (J > jw) ? sl2 : -sl2, nsl = -sgl; const float A0 = sgl * dl - mref, A1 = A0 - sgl * 32.0f; \
      _Pragma("unroll") for (int r = 0; r < 16; ++r) { const float off = (float)(16 * (r >> 3) + (r & 7)); s0[r] = __builtin_fmaf(nsl, off, A0); s1[r] = __builtin_fmaf(nsl, off, A1); } } \
    __builtin_amdgcn_sched_barrier(0); \
    _Pragma("unroll") for (int st = 0; st < 4; ++st) { s0 = __builtin_amdgcn_mfma_f32_32x32x16_bf16(kf[st][0], Qf[st], s0, 0, 0, 0); s1 = __builtin_amdgcn_mfma_f32_32x32x16_bf16(kf[st][1], Qf[st], s1, 0, 0, 0); } \
    _Pragma("unroll") for (int db = 0; db < 4; ++db) va[db] = *(const LAS bf16x8*)(bp + db * 4096 + vad[0]); \
    __builtin_amdgcn_sched_barrier(0); \
    float mx = s0[0]; \
    _Pragma("unroll") for (int r = 1; r < 16; ++r) mx = fmaxf(mx, s0[r]); \
    _Pragma("unroll") for (int r = 0; r < 16; ++r) mx = fmaxf(mx, s1[r]); \
    mx = fmaxf(mx, __shfl_xor(mx, 32)); \
    if (__any(mx > DTHR)) { const float dlt = mx > DTHR ? mx : 0.f, f = __builtin_amdgcn_exp2f(-dlt); mref += dlt; lrun *= f; \
      _Pragma("unroll") for (int r = 0; r < 16; ++r) { s0[r] -= dlt; s1[r] -= dlt; } \
      _Pragma("unroll") for (int db = 0; db < 4; ++db) _Pragma("unroll") for (int r = 0; r < 16; ++r) O[db][r] *= f; } \
    float ls = 0.f; \
    _Pragma("unroll") for (int r = 0; r < 16; ++r) { s0[r] = __builtin_amdgcn_exp2f(s0[r]); s1[r] = __builtin_amdgcn_exp2f(s1[r]); ls += s0[r] + s1[r]; } \
    lrun += ls; \
    _Pragma("unroll") for (int sx = 0; sx < 2; ++sx) { \
      pw[sx].x = pg8::cvt_pk_bf16(s0[8 * sx + 0], s0[8 * sx + 1]); pw[sx].y = pg8::cvt_pk_bf16(s0[8 * sx + 2], s0[8 * sx + 3]); pw[sx].z = pg8::cvt_pk_bf16(s0[8 * sx + 4], s0[8 * sx + 5]); pw[sx].w = pg8::cvt_pk_bf16(s0[8 * sx + 6], s0[8 * sx + 7]); \
      pw[2 + sx].x = pg8::cvt_pk_bf16(s1[8 * sx + 0], s1[8 * sx + 1]); pw[2 + sx].y = pg8::cvt_pk_bf16(s1[8 * sx + 2], s1[8 * sx + 3]); pw[2 + sx].z = pg8::cvt_pk_bf16(s1[8 * sx + 4], s1[8 * sx + 5]); pw[2 + sx].w = pg8::cvt_pk_bf16(s1[8 * sx + 6], s1[8 * sx + 7]); } \
  } while (0)
#define D_PV(t) do { const LAS unsigned char* bp = F.lds + ((t) & 3) * DSLOT; \
    _Pragma("unroll") for (int db = 0; db < 4; ++db) vb[db] = *(const LAS bf16x8*)(bp + db * 4096 + vad[1]); \
    _Pragma("unroll") for (int db = 0; db < 4; ++db) O[db] = __builtin_amdgcn_mfma_f32_32x32x16_bf16(va[db], __builtin_bit_cast(bf16x8, pw[0]), O[db], 0, 0, 0); \
    __builtin_amdgcn_sched_barrier(0); \
    _Pragma("unroll") for (int db = 0; db < 4; ++db) va[db] = *(const LAS bf16x8*)(bp + db * 4096 + vad[2]); \
    _Pragma("unroll") for (int db = 0; db < 4; ++db) O[db] = __builtin_amdgcn_mfma_f32_32x32x16_bf16(vb[db], __builtin_bit_cast(bf16x8, pw[1]), O[db], 0, 0, 0); \
    __builtin_amdgcn_sched_barrier(0); \
    _Pragma("unroll") for (int db = 0; db < 4; ++db) vb[db] = *(const LAS bf16x8*)(bp + db * 4096 + vad[3]); \
    _Pragma("unroll") for (int db = 0; db < 4; ++db) O[db] = __builtin_amdgcn_mfma_f32_32x32x16_bf16(va[db], __builtin_bit_cast(bf16x8, pw[2]), O[db], 0, 0, 0); \
    __builtin_amdgcn_sched_barrier(0); \
    if ((t) + 1 < NT) DKLOAD((t) + 1); \
    _Pragma("unroll") for (int db = 0; db < 4; ++db) O[db] = __builtin_amdgcn_mfma_f32_32x32x16_bf16(vb[db], __builtin_bit_cast(bf16x8, pw[3]), O[db], 0, 0, 0); \
    __builtin_amdgcn_sched_barrier(0); \
  } while (0)
#define D_BAR_EVEN(k) do { asm volatile("s_waitcnt vmcnt(0) lgkmcnt(0)" ::: "memory"); __builtin_amdgcn_s_barrier(); asm volatile("" ::: "memory"); __builtin_amdgcn_sched_barrier(0); if ((k) + 3 < NT) DDMA((k) + 3); } while (0)
#define D_BAR_ODD() do { asm volatile("s_waitcnt lgkmcnt(0)" ::: "memory"); __builtin_amdgcn_s_barrier(); asm volatile("" ::: "memory"); __builtin_amdgcn_sched_barrier(0); } while (0)
  DKLOAD(0);
  if (wid >= 4) { asm volatile("s_waitcnt lgkmcnt(0)" ::: "memory"); __builtin_amdgcn_s_barrier(); asm volatile("" ::: "memory"); }
  for (int t = 0; t < NT; ++t) { D_SM(t); D_BAR_EVEN(t); D_PV(t); D_BAR_ODD(); }
  if (wid < 4) { asm volatile("s_waitcnt lgkmcnt(0)" ::: "memory"); __builtin_amdgcn_s_barrier(); asm volatile("" ::: "memory"); }
#undef DDMA
#undef DKLOAD
#undef DJ
#undef D_SM
#undef D_PV
#undef D_BAR_EVEN
#undef D_BAR_ODD
  asm volatile("s_waitcnt lgkmcnt(0)" ::: "memory");
  __syncthreads();
  float lt = lrun; lt += __shfl_xor(lt, 32);
  const float inv = 1.0f / lt;
  LAS float* xch = (LAS float*)F.lds + (size_t)qg * 64 * 64 + lane;
  if (cw == 1) {
    const float sc = inv * lam;
#pragma unroll
    for (int db = 0; db < 4; ++db)
#pragma unroll
      for (int r = 0; r < 16; ++r) xch[(db * 16 + r) * 64] = O[db][r] * sc;
  }
  __syncthreads();
  if (cw == 1) return;
#pragma unroll
  for (int db = 0; db < 4; ++db)
#pragma unroll
    for (int r = 0; r < 16; ++r) O[db][r] = O[db][r] * inv - xch[(db * 16 + r) * 64];
  float ss = 0.f;
#pragma unroll
  for (int db = 0; db < 4; ++db)
#pragma unroll
    for (int r = 0; r < 16; ++r) ss += O[db][r] * O[db][r];
  ss += __shfl_xor(ss, 32);
  const float rn = rsqrtf(ss * (1.0f / 128) + EPS);
  bf16_t* op = ON + (tb + s_q) * D + 512 + h * 128 + 4 * hh;
#pragma unroll
  for (int db = 0; db < 4; ++db)
#pragma unroll
    for (int g4 = 0; g4 < 4; ++g4) { u32x2 w; w.x = pg8::cvt_pk_bf16(O[db][4 * g4 + 0] * rn, O[db][4 * g4 + 1] * rn); w.y = pg8::cvt_pk_bf16(O[db][4 * g4 + 2] * rn, O[db][4 * g4 + 3] * rn);
      *(u32x2*)(op + db * 32 + g4 * 8) = w; }
}
__device__ __forceinline__ void p2_attention(Frame& F, int p2sel) {
  const float lam = lam_value(F.lq1, F.lk1, F.lq2, F.lk2);
  constexpr int NDIFF = B * DFH * 32, NNA = B * NAH * 16;
  if (p2sel & 1) {
    const unsigned* qn2 = WSP(const unsigned, WS_QN2); const unsigned* kn2 = WSP(const unsigned, WS_KN2);
    for (int L = F.vcu; L < NDIFF; L += F.G) {
      const int h = 3 - (L >> 8), idx = L & 255, b = idx >> 5, qblk = idx & 31;
      const int hc = h * 2;
      const float qa = __builtin_bit_cast(float, __hip_atomic_load(qn2 + ((b * 8 + hc) * 32 + qblk), RLX_AGENT)), qb_ = __builtin_bit_cast(float, __hip_atomic_load(qn2 + ((b * 8 + hc + 1) * 32 + qblk), RLX_AGENT));
      const float ka = __builtin_bit_cast(float, __hip_atomic_load(kn2 + (b * 8 + hc), RLX_AGENT)), kb_ = __builtin_bit_cast(float, __hip_atomic_load(kn2 + (b * 8 + hc + 1), RLX_AGENT));
      const float bound = 2.0f * fmaxf(sqrtf(qa) * sqrtf(ka), sqrtf(qb_) * sqrtf(kb_)) * 1.01f;
      const float sl2 = exp2f(-2.0f * (float)(h + 1)) * LOG2E;
      const float dskip = (bound + 40.0f) / sl2;
      int jlo = (int)floorf((128.0f * qblk - dskip - 63.0f) * (1.0f / 64.0f)), jhi = (int)ceilf((dskip + 128.0f * qblk + 127.0f) * (1.0f / 64.0f));
      jlo = max(0, min(jlo, 2 * qblk)); jhi = min(S / 64 - 1, max(jhi, 2 * qblk + 1));
      diff_unit(F, b, h, qblk, lam, jlo, jhi);
    }
  }
  if (p2sel & 2) {
    for (int L = F.vcu; L < NNA; L += F.G) { const int qb = L & 15, bh = L >> 4; attn_unit<1>(F, bh >> 3, bh & 7, qb, lam); }
  }
}

__device__ __forceinline__ void p4_router(Frame& F) {
  LAS float* wl = (LAS float*)F.lds;
  __syncthreads();
  for (int i = F.tid; i < D * E; i += 512) { const int k = i >> 4, e = i & 15; wl[e * D + k] = F.w_router[i] * F.g_moe[k]; }
  __syncthreads();
  const bf16_t* H = (const bf16_t*)F.out; float* aff = WSP(float, WS_AFF); float* r2 = WSP(float, WS_R2);
  const int gw = F.vcu * 8 + F.wave, NGW = F.G * 8, lane = F.lane;
  for (int m = gw; m < T; m += NGW) {
    const u32x2* hr = (const u32x2*)(H + (size_t)m * D) + lane; f32x4 v[4]; float ss = 0.f;
#pragma unroll
    for (int j = 0; j < 4; ++j) { const u32x2 w = hr[64 * j]; v[j].x = bflo(w.x); v[j].y = bfhi(w.x); v[j].z = bflo(w.y); v[j].w = bfhi(w.y); ss += (v[j].x * v[j].x + v[j].y * v[j].y) + (v[j].z * v[j].z + v[j].w * v[j].w); }
    float lg[E];
#pragma unroll
    for (int e = 0; e < E; ++e) { float a = 0.f;
#pragma unroll
      for (int j = 0; j < 4; ++j) { const f32x4 w = *(const LAS f32x4*)(wl + e * D + 4 * lane + 256 * j); a += (v[j].x * w.x + v[j].y * w.y) + (v[j].z * w.z + v[j].w * w.w); }
      lg[e] = a; if ((e & 3) == 3) asm volatile("" ::: "memory"); }
    ss = wave_sum(ss);
    const float rn = rsqrtf(ss * (1.0f / D) + EPS);
    float a8[8], a4[4], a2[2], a1;
    { const bool up = (lane & 32) != 0;
#pragma unroll
      for (int e = 0; e < 8; ++e) { const float snd = up ? lg[e] : lg[e + 8], kp = up ? lg[e + 8] : lg[e]; a8[e] = kp + __shfl_xor(snd, 32); } }
    { const bool up = (lane & 16) != 0;
#pragma unroll
      for (int e = 0; e < 4; ++e) { const float snd = up ? a8[e] : a8[e + 4], kp = up ? a8[e + 4] : a8[e]; a4[e] = kp + __shfl_xor(snd, 16); } }
    { const bool up = (lane & 8) != 0;
#pragma unroll
      for (int e = 0; e < 2; ++e) { const float snd = up ? a4[e] : a4[e + 2], kp = up ? a4[e + 2] : a4[e]; a2[e] = kp + __shfl_xor(snd, 8); } }
    { const bool up = (lane & 4) != 0; const float snd = up ? a2[0] : a2[1], kp = up ? a2[1] : a2[0]; a1 = kp + __shfl_xor(snd, 4); }
    a1 += __shfl_xor(a1, 2); a1 += __shfl_xor(a1, 1);
    const float logit = a1 * rn;
    float mx = logit;
    mx = fmaxf(mx, __shfl_xor(mx, 4)); mx = fmaxf(mx, __shfl_xor(mx, 8)); mx = fmaxf(mx, __shfl_xor(mx, 16)); mx = fmaxf(mx, __shfl_xor(mx, 32));
    const float ex = expf(logit - mx);
    float den = ex;
    den += __shfl_xor(den, 4); den += __shfl_xor(den, 8); den += __shfl_xor(den, 16); den += __shfl_xor(den, 32);
    const int e = ((lane >> 5) & 1) * 8 + ((lane >> 4) & 1) * 4 + ((lane >> 3) & 1) * 2 + ((lane >> 2) & 1);
    const int b = m / S, s = m % S;
    if ((lane & 3) == 0) aff[((size_t)b * E + e) * S + s] = ex / den;
    if (lane == 0) r2[m] = rn;
  }
}

__device__ __forceinline__ void p5_topk(Frame& F) {
  LAS unsigned long long* key = (LAS unsigned long long*)F.lds;
  const float* aff = WSP(const float, WS_AFF); const float* r2 = WSP(const float, WS_R2);
  int* tok = WSP(int, WS_TOK); float* gsel = WSP(float, WS_GSEL); float* rsel = WSP(float, WS_RSEL); int* inv = WSP(int, WS_INV);
  for (int be = F.vcu; be < B * E; be += F.G) {
    const int b = be / E, e = be % E;
    __syncthreads();
    for (int i = F.tid; i < S; i += 512) { const unsigned bits = __builtin_bit_cast(unsigned, __hip_atomic_load(aff + (size_t)be * S + i, RLX_AGENT)); key[i] = ((unsigned long long)bits << 32) | (unsigned)(S - 1 - i); }
    __syncthreads();
    for (int k = 2; k <= S; k <<= 1)
      for (int j = k >> 1; j > 0; j >>= 1) {
        for (int p = F.tid; p < S / 2; p += 512) {
          const int i = ((p & ~(j - 1)) << 1) | (p & (j - 1)), ixj = i | j;
          const unsigned long long a = key[i], c = key[ixj];
          const bool desc = ((i & k) == 0);
          if (desc ? (a < c) : (a > c)) { key[i] = c; key[ixj] = a; }
        }
        __syncthreads();
      }
    for (int r = F.tid; r < S; r += 512) {
      const unsigned long long kv = key[r]; const int i = S - 1 - (int)(unsigned)(kv & 0xffffffffu);
      const int t = b * S + i;
      if (r < CAP) { const int row = be * CAP + r; tok[row] = t; gsel[row] = __builtin_bit_cast(float, (unsigned)(kv >> 32)); rsel[row] = __hip_atomic_load(r2 + t, RLX_AGENT); inv[(size_t)t * E + e] = r; }
      else inv[(size_t)t * E + e] = -1;
    }
  }
}

__device__ __forceinline__ void p8_combine(Frame& F) {
  const bf16_t* H = (const bf16_t*)F.out; const bf16_t* Y = WSP(const bf16_t, WS_VT); bf16_t* H2b = WSP(bf16_t, WS_XB); float* r3 = WSP(float, WS_R3); const int* inv = WSP(const int, WS_INV);
  const int gw = F.vcu * 8 + F.wave, NGW = F.G * 8, lane = F.lane;
  for (int m = gw; m < T; m += NGW) {
    const int b = m / S;
    const int iv = (lane < E) ? __hip_atomic_load(inv + (size_t)m * E + lane, RLX_AGENT) : -1;
    f32x4 a[4];
    const bf16_t* hp = H + (size_t)m * D + 8 * lane;
    { const u32x4 h0 = *(const u32x4*)hp, h1 = *(const u32x4*)(hp + 512);
      a[0].x = bflo(h0.x); a[0].y = bfhi(h0.x); a[0].z = bflo(h0.y); a[0].w = bfhi(h0.y); a[1].x = bflo(h0.z); a[1].y = bfhi(h0.z); a[1].z = bflo(h0.w); a[1].w = bfhi(h0.w);
      a[2].x = bflo(h1.x); a[2].y = bfhi(h1.x); a[2].z = bflo(h1.y); a[2].w = bfhi(h1.y); a[3].x = bflo(h1.z); a[3].y = bfhi(h1.z); a[3].z = bflo(h1.w); a[3].w = bfhi(h1.w); }
#pragma unroll
    for (int e = 0; e < E; ++e) {
      const int c = __builtin_amdgcn_readlane(iv, e);
      if (c >= 0) {
        const bf16_t* yp = Y + ((size_t)(b * E + e) * CAP + c) * D + 8 * lane;
        const u32x4 y0 = *(const u32x4*)yp, y1 = *(const u32x4*)(yp + 512);
        a[0].x += bflo(y0.x); a[0].y += bfhi(y0.x); a[0].z += bflo(y0.y); a[0].w += bfhi(y0.y); a[1].x += bflo(y0.z); a[1].y += bfhi(y0.z); a[1].z += bflo(y0.w); a[1].w += bfhi(y0.w);
        a[2].x += bflo(y1.x); a[2].y += bfhi(y1.x); a[2].z += bflo(y1.y); a[2].w += bfhi(y1.y); a[3].x += bflo(y1.z); a[3].y += bfhi(y1.z); a[3].z += bflo(y1.w); a[3].w += bfhi(y1.w);
      }
    }
    bf16_t* bp = H2b + (size_t)m * D + 8 * lane;
    u32x4 w0, w1; w0.x = pk2(a[0].x, a[0].y); w0.y = pk2(a[0].z, a[0].w); w0.z = pk2(a[1].x, a[1].y); w0.w = pk2(a[1].z, a[1].w);
    w1.x = pk2(a[2].x, a[2].y); w1.y = pk2(a[2].z, a[2].w); w1.z = pk2(a[3].x, a[3].y); w1.w = pk2(a[3].z, a[3].w);
    *(u32x4*)bp = w0; *(u32x4*)(bp + 512) = w1;
    float ss = 0.f;
    { const float q0 = bflo(w0.x), q1 = bfhi(w0.x), q2 = bflo(w0.y), q3 = bfhi(w0.y), q4 = bflo(w0.z), q5 = bfhi(w0.z), q6 = bflo(w0.w), q7 = bfhi(w0.w);
      const float p0 = bflo(w1.x), p1 = bfhi(w1.x), p2 = bflo(w1.y), p3 = bfhi(w1.y), p4 = bflo(w1.z), p5 = bfhi(w1.z), p6 = bflo(w1.w), p7 = bfhi(w1.w);
      ss = (q0 * q0 + q1 * q1) + (q2 * q2 + q3 * q3) + (q4 * q4 + q5 * q5) + (q6 * q6 + q7 * q7) + (p0 * p0 + p1 * p1) + (p2 * p2 + p3 * p3) + (p4 * p4 + p5 * p5) + (p6 * p6 + p7 * p7); }
    ss = wave_sum(ss);
    if (lane == 0) r3[m] = rsqrtf(ss * (1.0f / D) + EPS);
  }
}

__device__ __forceinline__ void p10_final(Frame& F) {
  float* H = F.out; const float* ssq = WSP(const float, WS_SSQ);
  const int gw = F.vcu * 8 + F.wave, NGW = F.G * 8, lane = F.lane;
  f32x4 g[4];
#pragma unroll
  for (int j = 0; j < 4; ++j) g[j] = ((const f32x4*)F.g_final)[lane + 64 * j];
  for (int m = gw; m < T; m += NGW) {
    const float rn = rsqrtf(__hip_atomic_load(ssq + m, RLX_AGENT) * (1.0f / D) + EPS);
    f32x4* hr = (f32x4*)(H + (size_t)m * D) + lane;
#pragma unroll
    for (int j = 0; j < 4; ++j) { f32x4 v = hr[64 * j]; v = v * rn * g[j]; hr[64 * j] = v; }
  }
}

__global__ void __launch_bounds__(512, 2) mega_fwd(Args args) {
  extern __shared__ __attribute__((aligned(16))) unsigned char lds_raw[];
  Frame F;
  F.lds = (LAS unsigned char*)lds_raw;
  F.tid = threadIdx.x; F.lane = F.tid & 63; F.wave = __builtin_amdgcn_readfirstlane(F.tid >> 6);
  F.G = gridDim.x; { const int bx = blockIdx.x; F.vcu = (F.G % 8 == 0) ? (bx % 8) * (F.G / 8) + bx / 8 : bx; }
  F.x = args.in[0]; F.p = args.in[1]; F.g_mix = args.in[2]; F.w_in = args.in[3]; F.rpb = args.in[4]; F.g_na = args.in[5];
  F.lq1 = args.in[6]; F.lk1 = args.in[7]; F.lq2 = args.in[8]; F.lk2 = args.in[9]; F.g_df = args.in[10]; F.w_out = args.in[11]; F.g_moe = args.in[12];
  F.w_router = args.in[13]; F.w_gate = args.in[14]; F.w_up = args.in[15]; F.w_down = args.in[16]; F.g_ple = args.in[17]; F.w_pg = args.in[18]; F.w_pp = args.in[19]; F.g_final = args.in[20];
  F.out = args.out; F.ws = args.ws;
  volatile LAS unsigned* MISC = (volatile LAS unsigned*)(F.lds + MISC_OFF);
  for (int u = F.tid; u < (LDS_BYTES - MISC_OFF) / 4; u += 512) MISC[u] = 0u;
  __syncthreads();
  const int lo = args.ph_lo, hi = args.ph_hi;
  const bool multi = (hi - lo) > 1;
  unsigned* barw = (unsigned*)(F.ws + WS_CTL) + CW_BAR + args.bar_li * 4096;
  XcdBarrier bar; bar.bar = barw; bar.x = 0; bar.st = nullptr;
  if (multi) bar = xcd_barrier_post(barw, MISC + 8);
#ifndef PH_MASK
#define PH_MASK 0xFFF
#endif
#define IN(k) ((((PH_MASK) >> (k)) & 1) && lo <= (k) && (k) < hi)
#ifndef REP_MASK
#define REP_MASK 0
#endif
#ifndef REP_P2SEL
#define REP_P2SEL 3
#endif
#ifndef REP_N
#define REP_N 2
#endif
#define REPS(k) (1 + (((REP_MASK) >> (k)) & 1) * (REP_N - 1))
#define SEAM(k) do { if (IN(k) && IN((k) + 1)) xcd_barrier(bar); } while (0)
  const LAS int* tokL = (const LAS int*)(F.lds + TOKL_OFF);

  if (IN(0)) for (int rep_ = 0; rep_ < REPS(0); ++rep_) { p0_prologue(F); if (rep_ + 1 < REPS(0)) xcd_barrier(bar); } SEAM(0);

  if (IN(1)) for (int rep_ = 0; rep_ < REPS(1); ++rep_) {
    { pg8::OrderStd S_; S_.init(T, NQK, D, F.G, (int)blockIdx.x); pg8::EpiQK E_{WSP(bf16_t, WS_QK), WSP(const float, WS_R1)};
      pg8::gemm_phase<pg8::EpiQK, pg8::OrderStd, true, false>(F.lds, (const char*)(F.ws + WS_XB), (const char*)(F.ws + WS_WQK), D, S_, E_, tokL); }
    { pg8::OrderStd S_; S_.init(NV, T, D, F.G, (int)blockIdx.x); pg8::EpiVT E_{WSP(bf16_t, WS_VT), WSP(const float, WS_R1)};
      pg8::gemm_phase<pg8::EpiVT, pg8::OrderStd, true, false>(F.lds, (const char*)(F.ws + WS_WV), (const char*)(F.ws + WS_XB), D, S_, E_, tokL); }
  if (rep_ + 1 < REPS(1)) xcd_barrier(bar); } SEAM(1);

  if (IN(2)) { p2n_norms(F); } SEAM(2);

  if (IN(3)) for (int rep_ = 0; rep_ < REPS(3); ++rep_) { p2_attention(F, rep_ == 0 ? args.pad : REP_P2SEL); if (rep_ + 1 < REPS(3)) xcd_barrier(bar); } SEAM(3);

  if (IN(4)) for (int rep_ = 0; rep_ < REPS(4); ++rep_) {
    pg8::OrderStd S_; S_.init(T, D, D, F.G, (int)blockIdx.x); pg8::EpiH E_{(bf16_t*)F.out, F.x};
    pg8::gemm_phase<pg8::EpiH, pg8::OrderStd, true, false>(F.lds, (const char*)(F.ws + WS_XB), (const char*)(F.ws + WS_WOUT), D, S_, E_, tokL);
  if (rep_ + 1 < REPS(4)) xcd_barrier(bar); } SEAM(4);

  if (IN(5)) for (int rep_ = 0; rep_ < REPS(5); ++rep_) { p4_router(F); if (rep_ + 1 < REPS(5)) xcd_barrier(bar); } SEAM(5);
  if (IN(6)) for (int rep_ = 0; rep_ < REPS(6); ++rep_) { p5_topk(F); if (rep_ + 1 < REPS(6)) xcd_barrier(bar); } SEAM(6);

  if (IN(7)) for (int rep_ = 0; rep_ < REPS(7); ++rep_) {
    pg8::OrderMoe S_; S_.G = F.G; S_.vcu = F.vcu; S_.upe = 128; S_.npn = 8; S_.total = 2048; S_.tstepA = 0; S_.tstepB = (size_t)256 * D * 2; S_.estepB = (size_t)2048 * D * 2;
    { LAS int* tl = (LAS int*)(F.lds + TOKL_OFF); const int* tok = WSP(const int, WS_TOK); pg8::Unit u;
      for (int i = 0; i < 8 && S_.next(i, u); ++i) for (int r = F.tid; r < 256; r += 512) tl[i * 256 + r] = __hip_atomic_load(tok + (size_t)u.pm * 256 + r, RLX_AGENT);
      __syncthreads(); }
    pg8::EpiMoe1 E_{WSP(bf16_t, WS_QK), WSP(const float, WS_RSEL)};
    pg8::gemm_phase<pg8::EpiMoe1, pg8::OrderMoe, true, true>(F.lds, (const char*)F.out, (const char*)(F.ws + WS_WGU), D, S_, E_, tokL);
  if (rep_ + 1 < REPS(7)) xcd_barrier(bar); } SEAM(7);

  if (IN(8)) for (int rep_ = 0; rep_ < REPS(8); ++rep_) {
    pg8::OrderMoe S_; S_.G = F.G; S_.vcu = F.vcu; S_.upe = 64; S_.npn = 4; S_.total = 1024; S_.tstepA = (size_t)256 * FF * 2; S_.tstepB = (size_t)256 * FF * 2; S_.estepB = (size_t)1024 * FF * 2;
    pg8::EpiRowScale E_{WSP(bf16_t, WS_VT), WSP(const float, WS_GSEL)};
    pg8::gemm_phase<pg8::EpiRowScale, pg8::OrderMoe, true, false>(F.lds, (const char*)(F.ws + WS_QK), (const char*)(F.ws + WS_WDN), FF, S_, E_, tokL);
  if (rep_ + 1 < REPS(8)) xcd_barrier(bar); } SEAM(8);

  if (IN(9)) {
    p8_combine(F);
    __syncthreads();
    int kpp = PLE; asm volatile("" : "+s"(kpp));
    pg8::OrderStd S_; S_.init(T, D, kpp, F.G, (int)blockIdx.x); pg8::EpiRowScale E_{WSP(bf16_t, WS_QK), nullptr};
    pg8::gemm_phase<pg8::EpiRowScale, pg8::OrderStd, true, false>(F.lds, (const char*)(F.ws + WS_PB), (const char*)(F.ws + WS_WPP), kpp, S_, E_, tokL);
  } SEAM(9);

  if (IN(10)) {
    pg8::OrderStd S_; S_.init(T, D, D, F.G, (int)blockIdx.x); pg8::EpiPle E_{F.out, WSP(const bf16_t, WS_XB), WSP(const bf16_t, WS_QK), WSP(const float, WS_R3), WSP(float, WS_SSQ)};
    pg8::gemm_phase<pg8::EpiPle, pg8::OrderStd, true, false>(F.lds, (const char*)(F.ws + WS_XB), (const char*)(F.ws + WS_WPG), D, S_, E_, tokL);
  } SEAM(10);

  if (IN(11)) { p10_final(F); }
#undef IN
#undef SEAM
}

namespace nv {
template <class Epi>
__global__ void __launch_bounds__(256) k_gemm(const bf16_t* __restrict__ A, int lda, const int* __restrict__ rowidx, int rows_per_z, const bf16_t* __restrict__ Bt, int ldb, size_t bstride_z, int zdiv, int K, Epi epi) {
  __shared__ float As[16][68]; __shared__ float Bs[16][68];
  const int tid = threadIdx.x, tx = tid & 15, ty = tid >> 4, z = blockIdx.z, m0 = blockIdx.y * 64, n0 = blockIdx.x * 64;
  const bf16_t* Bz = Bt + (size_t)(z % zdiv) * bstride_z;
  const int lr = tid >> 2, lk = (tid & 3) * 4;
  const int grow = z * rows_per_z + m0 + lr; const long arow = rowidx ? (long)rowidx[grow] : (long)grow;
  const bf16_t* Ap = A + arow * lda; const bf16_t* Bp = Bz + (size_t)(n0 + lr) * ldb;
  float acc[4][4];
#pragma unroll
  for (int i = 0; i < 4; ++i)
#pragma unroll
    for (int j = 0; j < 4; ++j) acc[i][j] = 0.f;
  for (int k0 = 0; k0 < K; k0 += 16) {
#pragma unroll
    for (int i = 0; i < 4; ++i) { As[lk + i][lr] = bf2f(Ap[k0 + lk + i]); Bs[lk + i][lr] = bf2f(Bp[k0 + lk + i]); }
    __syncthreads();
#pragma unroll
    for (int kk = 0; kk < 16; ++kk) { const float4 av = *(const float4*)&As[kk][ty * 4], bv = *(const float4*)&Bs[kk][tx * 4];
      const float a4[4] = {av.x, av.y, av.z, av.w}, b4[4] = {bv.x, bv.y, bv.z, bv.w};
#pragma unroll
      for (int i = 0; i < 4; ++i)
#pragma unroll
        for (int j = 0; j < 4; ++j) acc[i][j] = fmaf(a4[i], b4[j], acc[i][j]); }
    __syncthreads();
  }
#pragma unroll
  for (int i = 0; i < 4; ++i)
#pragma unroll
    for (int j = 0; j < 4; ++j) epi(z * rows_per_z + m0 + ty * 4 + i, n0 + tx * 4 + j, acc[i][j]);
}
struct EQK { bf16_t* O; const float* r1; __device__ void operator()(int m, int n, float a) const { O[(size_t)m * NQK + n] = (bf16_t)f2bf(a * r1[m]); } };
struct EVT { bf16_t* O; const float* r1; __device__ void operator()(int m, int n, float a) const { const int b = m / S, s = m % S; O[((size_t)b * NV + n) * S + s] = (bf16_t)f2bf(a * r1[m]); } };
struct EH { bf16_t* Hb; const float* X; __device__ void operator()(int m, int n, float a) const { const float v = X[(size_t)m * D + n] + a; Hb[(size_t)m * D + n] = (bf16_t)f2bf(v); } };
struct EM1 { float* G; __device__ void operator()(int m, int n, float a) const { G[(size_t)m * 2048 + n] = a; } };
struct ERS { bf16_t* O; const float* rs; __device__ void operator()(int m, int n, float a) const { O[(size_t)m * D + n] = (bf16_t)f2bf(rs ? a * rs[m] : a); } };
struct EPL { float* H; const bf16_t* H2; const bf16_t* PP; const float* r3; float* ssq; __device__ void operator()(int m, int n, float a) const {
  const float g = 1.0f / (1.0f + expf(-(r3[m] * a))); const float v = bf2f(H2[(size_t)m * D + n]) + g * bf2f(PP[(size_t)m * D + n]); H[(size_t)m * D + n] = v; atomicAdd(ssq + m, v * v); } };
__global__ void __launch_bounds__(256) k_moe1_post(const float* __restrict__ G, const float* __restrict__ rsel, bf16_t* __restrict__ hid, int row0, int nrows) {
  const size_t i = (size_t)blockIdx.x * 256 + threadIdx.x; if (i >= (size_t)nrows * FF) return;
  const int m = (int)(i / FF), f = (int)(i % FF); const float rs = rsel[row0 + m];
  const float g = G[(size_t)m * 2048 + (f >> 7) * 256 + (f & 127)] * rs, u = G[(size_t)m * 2048 + (f >> 7) * 256 + 128 + (f & 127)] * rs;
  hid[(size_t)(row0 + m) * FF + f] = (bf16_t)f2bf((g / (1.0f + expf(-g))) * u);
}
__global__ void __launch_bounds__(256) k_na(const bf16_t* __restrict__ QK, const bf16_t* __restrict__ VT, const float* __restrict__ rpb, bf16_t* __restrict__ ON) {
  const int gid = blockIdx.x * 256 + threadIdx.x; if (gid >= T * NAH) return;
  const int h = gid & 7, t = gid >> 3, b = t / S, s = t % S, r = s / GW, qc = s % GW;
  const int rs = min(max(r - 4, 0), ROWS - 8), cs = min(max(qc - 8, 0), GW - 16);
  float q[64]; const bf16_t* qp = QK + (size_t)t * NQK + h * 64;
#pragma unroll
  for (int d = 0; d < 64; ++d) q[d] = bf2f(qp[d]);
  float m = -INFINITY, l = 0.f, o[64];
#pragma unroll
  for (int d = 0; d < 64; ++d) o[d] = 0.f;
  for (int rr = 0; rr < 8; ++rr) for (int jj = 0; jj < 16; ++jj) {
    const int kc = cs + jj, sk = (rs + rr) * GW + kc; const bf16_t* kp = QK + ((size_t)b * S + sk) * NQK + 512 + h * 64;
    float sc = 0.f;
#pragma unroll
    for (int d = 0; d < 64; ++d) sc = fmaf(q[d], bf2f(kp[d]), sc);
    sc += rpb[(h * 15 + (rs + rr - r + 7)) * 31 + (kc - qc + 15)] * LOG2E;
    const float mn = fmaxf(m, sc), f = exp2f(m - mn), p = exp2f(sc - mn); l = l * f + p;
    const bf16_t* vp = VT + ((size_t)b * NV + h * 64) * S + sk;
#pragma unroll
    for (int d = 0; d < 64; ++d) o[d] = o[d] * f + p * bf2f(vp[(size_t)d * S]);
    m = mn; }
  const float inv = 1.0f / l; float ss = 0.f;
#pragma unroll
  for (int d = 0; d < 64; ++d) { o[d] *= inv; ss += o[d] * o[d]; }
  const float rn = rsqrtf(ss * (1.0f / 64) + EPS); bf16_t* op = ON + (size_t)t * D + h * 64;
#pragma unroll
  for (int d = 0; d < 64; ++d) op[d] = (bf16_t)f2bf(o[d] * rn);
}
__global__ void __launch_bounds__(256) k_diff(const bf16_t* __restrict__ QK, const bf16_t* __restrict__ VT, float* __restrict__ tmp, int b0) {
  int bid = blockIdx.x; const int qb = bid % (S / 256); bid /= (S / 256); const int vh = bid & 1; bid >>= 1; const int c = bid & 1; bid >>= 1; const int h = bid % DFH, bl = bid / DFH, b = b0 + bl;
  const int qi = qb * 256 + threadIdx.x; const size_t t = (size_t)b * S + qi, tl = (size_t)bl * S + qi;
  const float slope = exp2f(-2.0f * (h + 1)) * LOG2E;
  float q[64]; const bf16_t* qp = QK + t * NQK + 1024 + h * 128 + c * 64;
#pragma unroll
  for (int d = 0; d < 64; ++d) q[d] = bf2f(qp[d]);
  float m = -INFINITY, l = 0.f, o[64];
#pragma unroll
  for (int d = 0; d < 64; ++d) o[d] = 0.f;
  for (int j = 0; j < S; ++j) {
    const bf16_t* kp = QK + ((size_t)b * S + j) * NQK + 1536 + h * 128 + c * 64;
    float sc = 0.f;
#pragma unroll
    for (int d = 0; d < 64; ++d) sc = fmaf(q[d], bf2f(kp[d]), sc);
    sc -= slope * fabsf((float)(qi - j));
    const float mn = fmaxf(m, sc), f = exp2f(m - mn), p = exp2f(sc - mn); l = l * f + p;
    const bf16_t* vp = VT + ((size_t)b * NV + 512 + h * 128 + vh * 64) * S + j;
#pragma unroll
    for (int d = 0; d < 64; ++d) o[d] = o[d] * f + p * bf2f(vp[(size_t)d * S]);
    m = mn; }
  const float inv = 1.0f / l; float* op = tmp + ((tl * DFH + h) * 2 + c) * 128 + vh * 64;
#pragma unroll
  for (int d = 0; d < 64; ++d) op[d] = o[d] * inv;
}
__global__ void __launch_bounds__(256) k_diff_post(const float* __restrict__ tmp, const float* q1, const float* k1, const float* q2, const float* k2, bf16_t* __restrict__ ON, int b0) {
  const int w = (blockIdx.x * 256 + threadIdx.x) >> 6, lane = threadIdx.x & 63; if (w >= 4 * S * DFH) return;
  const int h = w % DFH, tl = w / DFH; const float lam = lam_value(q1, k1, q2, k2);
  const float* p0 = tmp + ((size_t)w * 2 + 0) * 128; const float* p1 = tmp + ((size_t)w * 2 + 1) * 128;
  const float a0 = p0[lane] - lam * p1[lane], a1 = p0[lane + 64] - lam * p1[lane + 64];
  const float ss = wave_sum(a0 * a0 + a1 * a1); const float rn = rsqrtf(ss * (1.0f / 128) + EPS);
  bf16_t* op = ON + ((size_t)b0 * S + tl) * D + 512 + h * 128; op[lane] = (bf16_t)f2bf(a0 * rn); op[lane + 64] = (bf16_t)f2bf(a1 * rn);
}
__global__ void __launch_bounds__(256) k_router(const bf16_t* __restrict__ h, const float* __restrict__ gmoe, const float* __restrict__ wr, float* __restrict__ aff, float* __restrict__ r2) {
  const int w = (blockIdx.x * 256 + threadIdx.x) >> 6, lane = threadIdx.x & 63; if (w >= T) return;
  const bf16_t* hr = h + (size_t)w * D; float ss = 0.f, lg[E];
#pragma unroll
  for (int e = 0; e < E; ++e) lg[e] = 0.f;
  for (int k = lane; k < D; k += 64) { const float v = bf2f(hr[k]); ss += v * v; const float vg = v * gmoe[k]; const float* wp = wr + (size_t)k * E;
#pragma unroll
    for (int e = 0; e < E; ++e) lg[e] = fmaf(vg, wp[e], lg[e]); }
  ss = wave_sum(ss); const float rn = rsqrtf(ss * (1.0f / D) + EPS); float mx = -INFINITY;
#pragma unroll
  for (int e = 0; e < E; ++e) { lg[e] = wave_sum(lg[e]) * rn; mx = fmaxf(mx, lg[e]); }
  float den = 0.f;
#pragma unroll
  for (int e = 0; e < E; ++e) { lg[e] = expf(lg[e] - mx); den += lg[e]; }
  const int b = w / S, s = w % S;
  if (lane < E) { float v = 0.f;
#pragma unroll
    for (int e = 0; e < E; ++e) if (lane == e) v = lg[e];
    aff[((size_t)b * E + lane) * S + s] = v / den; }
  if (lane == 0) r2[w] = rn;
}
__global__ void __launch_bounds__(512) k_topk(const float* __restrict__ aff, const float* __restrict__ r2, int* __restrict__ tok, float* __restrict__ gsel, float* __restrict__ rsel, int* __restrict__ inv) {
  __shared__ float a[S]; const int be = blockIdx.x, b = be / E, e = be % E; const float* ap = aff + (size_t)be * S;
  for (int i = threadIdx.x; i < S; i += 512) a[i] = ap[i];
  __syncthreads();
  for (int i = threadIdx.x; i < S; i += 512) { const float v = a[i]; int rank = 0;
    for (int j = 0; j < S; ++j) { const float u = a[j]; rank += (u > v || (u == v && j < i)) ? 1 : 0; }
    const int t = b * S + i;
    if (rank < CAP) { const int row = be * CAP + rank; tok[row] = t; gsel[row] = v; rsel[row] = r2[t]; inv[(size_t)t * E + e] = rank; } else inv[(size_t)t * E + e] = -1; }
}
__global__ void __launch_bounds__(256) k_combine(const bf16_t* __restrict__ H, const bf16_t* __restrict__ Y, const int* __restrict__ inv, bf16_t* __restrict__ H2b, float* __restrict__ r3) {
  const int w = (blockIdx.x * 256 + threadIdx.x) >> 6, lane = threadIdx.x & 63; if (w >= T) return;
  const int b = w / S; float ss = 0.f;
  for (int k = lane; k < D; k += 64) { float v = bf2f(H[(size_t)w * D + k]);
    for (int e = 0; e < E; ++e) { const int c = inv[(size_t)w * E + e]; if (c >= 0) v += bf2f(Y[((size_t)(b * E + e) * CAP + c) * D + k]); }
    const bf16_t vb = (bf16_t)f2bf(v); H2b[(size_t)w * D + k] = vb; const float vr = bf2f(vb); ss += vr * vr; }
  ss = wave_sum(ss); if (lane == 0) r3[w] = rsqrtf(ss * (1.0f / D) + EPS);
}
__global__ void __launch_bounds__(256) k_final(float* __restrict__ H, const float* __restrict__ ssq, const float* __restrict__ g) {
  const int w = (blockIdx.x * 256 + threadIdx.x) >> 6, lane = threadIdx.x & 63; if (w >= T) return;
  const float rn = rsqrtf(ssq[w] * (1.0f / D) + EPS);
  for (int k = lane; k < D; k += 64) H[(size_t)w * D + k] = H[(size_t)w * D + k] * rn * g[k];
}
}

static void launch_naive(int ph, void* const* d_in, float* out, unsigned char* ws, hipStream_t st) {
  using namespace nv;
  auto W = [&](size_t off) { return ws + off; };
  const float* x = (const float*)d_in[0];
  switch (ph) {
    case 1:
      k_gemm<EQK><<<dim3(NQK / 64, T / 64, 1), 256, 0, st>>>((const bf16_t*)W(WS_XB), D, nullptr, 0, (const bf16_t*)W(WS_WQK), D, 0, 1, D, EQK{(bf16_t*)W(WS_QK), (const float*)W(WS_R1)});
      k_gemm<EVT><<<dim3(NV / 64, T / 64, 1), 256, 0, st>>>((const bf16_t*)W(WS_XB), D, nullptr, 0, (const bf16_t*)W(WS_WV), D, 0, 1, D, EVT{(bf16_t*)W(WS_VT), (const float*)W(WS_R1)});
      break;
    case 3:
      k_na<<<T * NAH / 256, 256, 0, st>>>((const bf16_t*)W(WS_QK), (const bf16_t*)W(WS_VT), (const float*)d_in[4], (bf16_t*)W(WS_XB));
      for (int half = 0; half < 2; ++half) {
        k_diff<<<4 * DFH * 2 * 2 * (S / 256), 256, 0, st>>>((const bf16_t*)W(WS_QK), (const bf16_t*)W(WS_VT), out, half * 4);
        k_diff_post<<<4 * S * DFH / 4, 256, 0, st>>>(out, (const float*)d_in[6], (const float*)d_in[7], (const float*)d_in[8], (const float*)d_in[9], (bf16_t*)W(WS_XB), half * 4);
      }
      break;
    case 21:
      k_na<<<T * NAH / 256, 256, 0, st>>>((const bf16_t*)W(WS_QK), (const bf16_t*)W(WS_VT), (const float*)d_in[4], (bf16_t*)W(WS_XB));
      break;
    case 22:
      for (int half = 0; half < 2; ++half) {
        k_diff<<<4 * DFH * 2 * 2 * (S / 256), 256, 0, st>>>((const bf16_t*)W(WS_QK), (const bf16_t*)W(WS_VT), out, half * 4);
        k_diff_post<<<4 * S * DFH / 4, 256, 0, st>>>(out, (const float*)d_in[6], (const float*)d_in[7], (const float*)d_in[8], (const float*)d_in[9], (bf16_t*)W(WS_XB), half * 4);
      }
      break;
    case 4:
      k_gemm<EH><<<dim3(D / 64, T / 64, 1), 256, 0, st>>>((const bf16_t*)W(WS_XB), D, nullptr, 0, (const bf16_t*)W(WS_WOUT), D, 0, 1, D, EH{(bf16_t*)out, x});
      break;
    case 5:
      k_router<<<T / 4, 256, 0, st>>>((const bf16_t*)out, (const float*)d_in[12], (const float*)d_in[13], (float*)W(WS_AFF), (float*)W(WS_R2));
      break;
    case 6:
      k_topk<<<B * E, 512, 0, st>>>((const float*)W(WS_AFF), (const float*)W(WS_R2), (int*)W(WS_TOK), (float*)W(WS_GSEL), (float*)W(WS_RSEL), (int*)W(WS_INV));
      break;
    case 7:
      for (int ch = 0; ch < 8; ++ch) {
        float* G = (float*)W(388 * MiB);
        k_gemm<EM1><<<dim3(2048 / 64, CAP / 64, 16), 256, 0, st>>>((const bf16_t*)out, D, (const int*)W(WS_TOK) + ch * 8192, CAP, (const bf16_t*)W(WS_WGU), D, (size_t)2048 * D, E, D, EM1{G});
        k_moe1_post<<<8192 * FF / 256, 256, 0, st>>>(G, (const float*)W(WS_RSEL), (bf16_t*)W(WS_QK), ch * 8192, 8192);
      }
      break;
    case 8:
      k_gemm<ERS><<<dim3(D / 64, CAP / 64, B * E), 256, 0, st>>>((const bf16_t*)W(WS_QK), FF, nullptr, CAP, (const bf16_t*)W(WS_WDN), FF, (size_t)1024 * FF, E, FF, ERS{(bf16_t*)W(WS_VT), (const float*)W(WS_GSEL)});
      break;
    case 9:
      k_combine<<<T / 4, 256, 0, st>>>((const bf16_t*)out, (const bf16_t*)W(WS_VT), (const int*)W(WS_INV), (bf16_t*)W(WS_XB), (float*)W(WS_R3));
      k_gemm<ERS><<<dim3(D / 64, T / 64, 1), 256, 0, st>>>((const bf16_t*)W(WS_PB), PLE, nullptr, 0, (const bf16_t*)W(WS_WPP), PLE, 0, 1, PLE, ERS{(bf16_t*)W(WS_QK), nullptr});
      break;
    case 10:
      k_gemm<EPL><<<dim3(D / 64, T / 64, 1), 256, 0, st>>>((const bf16_t*)W(WS_XB), D, nullptr, 0, (const bf16_t*)W(WS_WPG), D, 0, 1, D, EPL{out, (const bf16_t*)W(WS_XB), (const bf16_t*)W(WS_QK), (const float*)W(WS_R3), (float*)W(WS_SSQ)});
      break;
    case 11:
      k_final<<<T / 4, 256, 0, st>>>(out, (const float*)W(WS_SSQ), (const float*)d_in[20]);
      break;
    default: break;
  }
}

extern "C" void kernel_launch(void* const* d_in, const int* in_sizes, int n_in, void* d_out, int out_size, void* d_ws, size_t ws_size, hipStream_t stream) {
  static int grid = 0;
  if (grid == 0) {
    int dev = 0, cus = 0, per_cu = 0;
    if (n_in != 21 || out_size != T * D || ws_size < WS_END) { fprintf(stderr, "kernel_launch: unexpected problem (n_in %d out %d ws %zu)\n", n_in, out_size, ws_size); grid = -1; return; }
    hipGetDevice(&dev); hipDeviceGetAttribute(&cus, hipDeviceAttributeMultiprocessorCount, dev);
    hipFuncSetAttribute((const void*)mega_fwd, hipFuncAttributeMaxDynamicSharedMemorySize, LDS_BYTES);
    if (hipOccupancyMaxActiveBlocksPerMultiprocessor(&per_cu, (const void*)mega_fwd, 512, LDS_BYTES) != hipSuccess || per_cu < 1) { fprintf(stderr, "kernel_launch: occupancy query says %d blocks per CU\n", per_cu); per_cu = 1; }
    (void)hipGetLastError();
    grid = cus;
  }
  if (grid < 0) return;
  hipMemsetAsync((char*)d_ws + WS_CTL, 0, CTL_ZERO_BYTES, stream);
  Args a{};
  for (int i = 0; i < 21; ++i) a.in[i] = (const float*)d_in[i];
  a.out = (float*)d_out; a.ws = (unsigned char*)d_ws;
  constexpr int NPH = 12;
  int ph = 0, nbar = 0;
  while (ph < NPH) {
    if ((NAIVE_MASK >> ph) & 1) { launch_naive(ph, d_in, (float*)d_out, (unsigned char*)d_ws, stream); ++ph; continue; }
    int hi = ph + 1; while (hi < NPH && !((NAIVE_MASK >> hi) & 1) && !((CUT_MASK >> (hi - 1)) & 1)) ++hi;
    a.ph_lo = ph; a.ph_hi = hi; a.bar_li = nbar; if (hi - ph > 1) ++nbar;
    a.pad = P2_RUN;
    hipLaunchKernelGGL(mega_fwd, dim3(grid), dim3(512), LDS_BYTES, stream, a);
    if (ph <= 3 && 3 < hi && P2_RUN != 3) launch_naive(P2_RUN == 1 ? 21 : 22, d_in, (float*)d_out, (unsigned char*)d_ws, stream);
    ph = hi;
  }
}
```
